# Optimizing an MI355X kernel written in HIP

```python
import jax
import jax.numpy as jnp
from jax import lax
import numpy as np

D_MODEL = 1024
BATCH = 16
SEQ = 2048
DEPTH = 2

HEAD_DIM = 64
DIL_PATTERNS = ((128, 1), (512, 4), (2048, 16))
DIL_HEADS_PER_GROUP = 4
DIL_HEADS = len(DIL_PATTERNS) * DIL_HEADS_PER_GROUP
DIL_QBLOCK = 64
NA_HEADS = 8
GRID_W = 64
NA_ROWS_MAX = 8
NA_COLS = 16
NA_QCOLS = 16
D_FF = 2816
ROPE_THETA = 10000.0
RMS_EPS = 1e-6
NEG_INF = -1e30
DIL_QKV = 3 * DIL_HEADS * HEAD_DIM
NA_QKV = 3 * NA_HEADS * HEAD_DIM
IN_WIDTH = DIL_QKV + NA_QKV + 2 * D_MODEL

kernel_name = 'hybrid_dilated_neighbourhood_macaron'


def rms_norm(x, g):
    x32 = x.astype(jnp.float32)
    y = x32 * lax.rsqrt(jnp.mean(x32 * x32, axis=-1, keepdims=True) + RMS_EPS)
    return (y * g.astype(jnp.float32)).astype(x.dtype)


def swiglu(x, w_up, w_down):
    gate, up = jnp.split(x @ w_up, 2, axis=-1)
    return (jax.nn.silu(gate) * up) @ w_down


def rotary(t, pos):
    half = HEAD_DIM // 2
    inv_freq = ROPE_THETA ** (-jnp.arange(half, dtype=jnp.float32) / half)
    ang = pos.astype(jnp.float32)[:, None] * inv_freq[None, :]
    cos = jnp.cos(ang).astype(t.dtype)
    sin = jnp.sin(ang).astype(t.dtype)
    t1, t2 = t[..., :half], t[..., half:]
    return jnp.concatenate([t1 * cos - t2 * sin, t2 * cos + t1 * sin], axis=-1)


def dilated_window_attention(q, k, v, dilation, half):
    b, g, s, hd = q.shape
    sub_len = s // dilation
    bq = min(DIL_QBLOCK, sub_len)
    nb = -(-sub_len // bq)
    padded = nb * bq
    nk = bq + 2 * half

    def to_sub(t):
        return t.reshape(b, g, sub_len, dilation, hd).transpose(0, 1, 3, 2, 4)

    qs = jnp.pad(to_sub(q), ((0, 0), (0, 0), (0, 0), (0, padded - sub_len), (0, 0)))
    qs = qs.reshape(b, g, dilation, nb, bq, hd)
    key_idx = np.arange(nb)[:, None] * bq + np.arange(nk)[None, :]
    kpad = ((0, 0), (0, 0), (0, 0), (half, padded - sub_len + half), (0, 0))
    ks = jnp.pad(to_sub(k), kpad)[:, :, :, key_idx]
    vs = jnp.pad(to_sub(v), kpad)[:, :, :, key_idx]
    q_pos = np.arange(nb)[:, None] * bq + np.arange(bq)[None, :]
    k_pos = key_idx - half
    rel = k_pos[:, None, :] - q_pos[:, :, None]
    valid = (np.abs(rel) <= half) & (k_pos[:, None, :] >= 0) & (k_pos[:, None, :] < sub_len)
    scores = jnp.einsum('bgrnqd,bgrnkd->bgrnqk', qs, ks).astype(jnp.float32) * (hd ** -0.5)
    scores = jnp.where(valid, scores, NEG_INF)
    m = jnp.max(scores, axis=-1, keepdims=True)
    p = jnp.exp(scores - m)
    den = jnp.sum(p, axis=-1)
    o = jnp.einsum('bgrnqk,bgrnkd->bgrnqd', p.astype(v.dtype), vs).astype(jnp.float32) / den[..., None]
    lse = m[..., 0] + jnp.log(den)
    o = o.reshape(b, g, dilation, padded, hd)[:, :, :, :sub_len]
    o = o.transpose(0, 1, 3, 2, 4).reshape(b, g, s, hd)
    lse = lse.reshape(b, g, dilation, padded)[..., :sub_len].transpose(0, 1, 3, 2).reshape(b, g, s)
    return o, lse


def neighbourhood_attention(q, k, v, rel_bias):
    b, nh, s, hd = q.shape
    rows = s // GRID_W
    kr = min(NA_ROWS_MAX, rows)
    n_cb = GRID_W // NA_QCOLS
    kcw = 2 * NA_QCOLS
    q_cols = np.arange(GRID_W).reshape(n_cb, NA_QCOLS)
    key_cols = (np.clip(np.arange(n_cb) * NA_QCOLS - NA_QCOLS // 2, 0, GRID_W - kcw)[:, None]
                + np.arange(kcw)[None, :])
    win_lo = np.clip(q_cols - NA_COLS // 2, 0, GRID_W - NA_COLS)
    col_valid = ((key_cols[:, None, :] >= win_lo[:, :, None])
                 & (key_cols[:, None, :] < win_lo[:, :, None] + NA_COLS))
    col_idx = np.clip(key_cols[:, None, :] - q_cols[:, :, None] + NA_COLS - 1, 0, 2 * NA_COLS - 2)
    row_ids = np.arange(rows)
    row_lo = np.clip(row_ids - kr // 2, 0, rows - kr)
    row_idx = row_lo[:, None] + np.arange(kr)[None, :] - row_ids[:, None] + NA_ROWS_MAX - 1
    bias = rel_bias.astype(jnp.float32)[:, row_idx][..., col_idx]
    bias = jnp.where(col_valid[:, :, None, :], bias.transpose(1, 0, 3, 4, 2, 5), NEG_INF)
    kg = k.reshape(b, nh, rows, GRID_W, hd)
    vg = v.reshape(b, nh, rows, GRID_W, hd)
    q_rows = q.reshape(b, nh, rows, n_cb, NA_QCOLS, hd).transpose(2, 0, 1, 3, 4, 5)
    scale = hd ** -0.5

    def one_row(args):
        q_r, lo, bias_r = args
        k_r = lax.dynamic_slice_in_dim(kg, lo, kr, axis=2)[:, :, :, key_cols]
        v_r = lax.dynamic_slice_in_dim(vg, lo, kr, axis=2)[:, :, :, key_cols]
        sc = jnp.einsum('bhcqd,bhrckd->bhcqrk', q_r, k_r).astype(jnp.float32) * scale + bias_r
        p = jax.nn.softmax(sc.reshape(b, nh, n_cb, NA_QCOLS, kr * kcw), axis=-1).reshape(sc.shape)
        return jnp.einsum('bhcqrk,bhrckd->bhcqd', p.astype(v.dtype), v_r)

    out = lax.map(one_row, (q_rows, jnp.asarray(row_lo, dtype=jnp.int32), bias))
    return out.reshape(rows, b, nh, GRID_W, hd).transpose(1, 2, 0, 3, 4).reshape(b, nh, s, hd)


def hybrid_mixer(h, w_in, rel_bias, w_branch_a, w_branch_b, w_out, pos):
    b, s, _ = h.shape
    proj = h @ w_in
    a_qkv = proj[..., :DIL_QKV]
    b_qkv = proj[..., DIL_QKV:DIL_QKV + NA_QKV]
    gate_a, gate_b = jnp.split(jax.nn.sigmoid(proj[..., DIL_QKV + NA_QKV:]), 2, axis=-1)

    def heads(t, n):
        return t.reshape(b, s, n, HEAD_DIM).transpose(0, 2, 1, 3)

    qa, ka, va = (heads(t, DIL_HEADS) for t in jnp.split(a_qkv, 3, axis=-1))
    qa, ka = rotary(qa, pos), rotary(ka, pos)
    outs, lses = [], []
    for gi, (window, dilation) in enumerate(DIL_PATTERNS):
        grp = slice(gi * DIL_HEADS_PER_GROUP, (gi + 1) * DIL_HEADS_PER_GROUP)
        o, lse = dilated_window_attention(qa[:, grp], ka[:, grp], va[:, grp], dilation, (window // 2) // dilation)
        outs.append(o)
        lses.append(lse)
    mix_w = jax.nn.softmax(jnp.stack(lses), axis=0)
    ya = jnp.sum(mix_w[..., None] * jnp.stack(outs), axis=0).astype(h.dtype)
    ya = ya.transpose(0, 2, 1, 3).reshape(b, s, DIL_HEADS_PER_GROUP * HEAD_DIM)

    qb, kb, vb = (heads(t, NA_HEADS) for t in jnp.split(b_qkv, 3, axis=-1))
    yb = neighbourhood_attention(qb, kb, vb, rel_bias)
    yb = yb.transpose(0, 2, 1, 3).reshape(b, s, NA_HEADS * HEAD_DIM)

    merged = gate_a * (ya @ w_branch_a) + gate_b * (yb @ w_branch_b)
    return merged @ w_out


def setup_inputs(seed: int = 0) -> dict:
    key = jax.random.key(seed)
    ks = jax.random.split(key, 14)
    f32 = jnp.float32

    def normal(k, shape, scale):
        return jax.random.normal(k, shape, f32) * scale

    def gain(k, shape):
        return 1.0 + 0.05 * jax.random.normal(k, shape, f32)

    return {
        'x': normal(ks[0], (BATCH, SEQ, D_MODEL), 1.0),
        'ffn1_norm': gain(ks[1], (DEPTH, D_MODEL)),
        'ffn1_w_up': normal(ks[2], (DEPTH, D_MODEL, 2 * D_FF), D_MODEL ** -0.5),
        'ffn1_w_down': normal(ks[3], (DEPTH, D_FF, D_MODEL), D_FF ** -0.5),
        'mix_norm': gain(ks[4], (DEPTH, D_MODEL)),
        'w_in': normal(ks[5], (DEPTH, D_MODEL, IN_WIDTH), D_MODEL ** -0.5),
        'na_rel_bias': normal(ks[6], (DEPTH, NA_HEADS, 2 * NA_ROWS_MAX - 1, 2 * NA_COLS - 1), 0.1),
        'w_branch_a': normal(ks[7], (DEPTH, DIL_HEADS_PER_GROUP * HEAD_DIM, D_MODEL), (DIL_HEADS_PER_GROUP * HEAD_DIM) ** -0.5),
        'w_branch_b': normal(ks[8], (DEPTH, NA_HEADS * HEAD_DIM, D_MODEL), (NA_HEADS * HEAD_DIM) ** -0.5),
        'w_out': normal(ks[9], (DEPTH, D_MODEL, D_MODEL), D_MODEL ** -0.5),
        'ffn2_norm': gain(ks[10], (DEPTH, D_MODEL)),
        'ffn2_w_up': normal(ks[11], (DEPTH, D_MODEL, 2 * D_FF), D_MODEL ** -0.5),
        'ffn2_w_down': normal(ks[12], (DEPTH, D_FF, D_MODEL), D_FF ** -0.5),
        'final_norm': gain(ks[13], (D_MODEL,)),
    }


def reference(x, ffn1_norm, ffn1_w_up, ffn1_w_down, mix_norm, w_in, na_rel_bias, w_branch_a,
              w_branch_b, w_out, ffn2_norm, ffn2_w_up, ffn2_w_down, final_norm):
    pos = jnp.arange(x.shape[1])
    for l in range(DEPTH):
        x = x + 0.5 * swiglu(rms_norm(x, ffn1_norm[l]), ffn1_w_up[l], ffn1_w_down[l])
        x = x + hybrid_mixer(rms_norm(x, mix_norm[l]), w_in[l], na_rel_bias[l], w_branch_a[l],
                             w_branch_b[l], w_out[l], pos)
        x = x + 0.5 * swiglu(rms_norm(x, ffn2_norm[l]), ffn2_w_up[l], ffn2_w_down[l])
    return rms_norm(x, final_norm)
```

```cpp
#include <hip/hip_runtime.h>
#include <hip/hip_cooperative_groups.h>
#include <cstdio>
#include <cstdint>
#include <cmath>
namespace cg = cooperative_groups;

namespace pg8 {
#define PG8_LAS __attribute__((address_space(3)))
typedef unsigned short bf16_t;
typedef short bf16x8 __attribute__((ext_vector_type(8)));
typedef float f32x4 __attribute__((ext_vector_type(4)));
typedef unsigned u32x4 __attribute__((ext_vector_type(4)));
constexpr int BM = 256, BK = 64, HALF = 128, HTB = HALF * BK * 2, STAGE_BYTES = 8 * HTB, NXCD = 8, WGM = 4;

__host__ __device__ __forceinline__ int lds_byte(int r, int c) { const int st = (r >> 4) * 2 + (c >> 5), rr = r & 15, cc = c & 31, ob = rr * 64 + cc * 2; return st * 1024 + (ob ^ (((ob >> 9) & 1) << 5)); }
__host__ __device__ __forceinline__ void stage_rc(int b, int& R, int& C) { const int st = b / 1024, sb = b % 1024, swz = sb ^ (((sb >> 9) & 1) << 5); R = (st >> 1) * 16 + swz / 64; C = (st & 1) * 32 + (swz % 64) / 2; }
__host__ __device__ __forceinline__ int perm32(int rho) { const int n = rho >> 4, i = rho & 15; return 8 * (i >> 2) + 4 * n + (i & 3); }

struct Unit { int pm, pn; };
struct Gemm { const bf16_t* A; const bf16_t* Bt; int M, N, K; };

struct StaticOrder {
    int nM, nN, nwg, G, c;
    __host__ __device__ void init(int M, int N, int G_, int c_) { nM = M / BM; nN = N / BM; nwg = nM * nN; G = G_; c = c_; }
    __host__ __device__ bool next(int i, Unit& u) const {
        const long L = (long)i * G + c; if (L >= nwg) return false;
        int wgid = (int)L; { const int q = nwg / NXCD, r = nwg % NXCD, xcd = wgid % NXCD, off = wgid / NXCD; wgid = (xcd < r ? xcd * (q + 1) : r * (q + 1) + (xcd - r) * q) + off; }
        const int nig = WGM * nN, gid = wgid / nig, fm = gid * WGM, gsz = (nM - fm) < WGM ? (nM - fm) : WGM;
        u.pm = fm + ((wgid % nig) % gsz); u.pn = (wgid % nig) / gsz; return true;
    }
    __device__ __forceinline__ void a_ready(const Unit&) const {}
    __device__ __forceinline__ void done(const Unit&) const {}
};

template <class Epi, class Sched, bool ALIGN_EPI = false, bool SP2 = false>
__device__ __forceinline__ void gemm_phase(PG8_LAS unsigned char* lds, const Gemm g, const Sched& S, const Epi& E, const int tid_in) {
    const int tid = tid_in, wid = __builtin_amdgcn_readfirstlane(tid >> 6), lane = tid & 63, wr = wid >> 2, wc = wid & 3, fr = lane & 15, fq = lane >> 4;
    const int K = g.K, nt = K / BK;
    unsigned voffA[2], voffB[2];
#pragma unroll
    for (int i = 0; i < 2; ++i) { int R, C; stage_rc(tid * 16 + i * 8192, R, C); const int Rb = Epi::PERM ? ((R & ~31) + perm32(R & 31)) : R;
        voffA[i] = (unsigned)(R * K + C) * 2u; voffB[i] = (unsigned)(Rb * K + C) * 2u; }
    const size_t kstep = (size_t)(BK * 2);
    const size_t hstep = (size_t)HALF * K * 2;
    const size_t tstep = 2 * hstep;
    const unsigned ldsw = (unsigned)wid * 1024u;
    const int aoff = lds_byte(wr * 64 + fr, fq * 8), boff = lds_byte(wc * 32 + fr, fq * 8);
#define PG8_SA(b, h) (((b) * 2 + (h)) * HTB)
#define PG8_SB(b, h) ((4 + (b) * 2 + (h)) * HTB)
#define PG8_STAGE(bufoff, gbase, voff) do { _Pragma("unroll") for (int _i = 0; _i < 2; ++_i) \
        __builtin_amdgcn_global_load_lds((const unsigned*)((const char*)(gbase) + (voff)[_i]), (PG8_LAS unsigned*)(lds + (bufoff) + ldsw + _i * 8192), 16, 0, 0); } while (0)
#define PG8_LDA(dst, b, h) do { _Pragma("unroll") for (int m = 0; m < 4; ++m) _Pragma("unroll") for (int k = 0; k < 2; ++k) dst[m][k] = *(const PG8_LAS bf16x8*)(lds + PG8_SA(b, h) + aoff + m * 2048 + k * 1024); } while (0)
#define PG8_LDB(dst, b, h) do { _Pragma("unroll") for (int n = 0; n < 2; ++n) _Pragma("unroll") for (int k = 0; k < 2; ++k) dst[n][k] = *(const PG8_LAS bf16x8*)(lds + PG8_SB(b, h) + boff + n * 2048 + k * 1024); } while (0)
#define PG8_MMA(ai, bj, At, Bt) do { __builtin_amdgcn_s_setprio(1); _Pragma("unroll") for (int m = 0; m < 4; ++m) _Pragma("unroll") for (int n = 0; n < 2; ++n) _Pragma("unroll") for (int k = 0; k < 2; ++k) \
        acc[ai][bj][m][n] = __builtin_amdgcn_mfma_f32_16x16x32_bf16(Bt[n][k], At[m][k], acc[ai][bj][m][n], 0, 0, 0); __builtin_amdgcn_s_setprio(0); } while (0)
#define PG8_WAIT_V(n) asm volatile("s_waitcnt vmcnt(" #n ")" ::: "memory")
#define PG8_WAIT_L(n) asm volatile("s_waitcnt lgkmcnt(" #n ")" ::: "memory")
#define PG8_BAR __builtin_amdgcn_s_barrier()
#define PG8_SCHED __builtin_amdgcn_sched_barrier(0)
    Unit cur, nxt; int ui = 0;
    if (!S.next(0, cur)) return;
    f32x4 acc[2][2][4][2];
#pragma unroll
    for (int a = 0; a < 2; ++a)
#pragma unroll
        for (int b = 0; b < 2; ++b)
#pragma unroll
            for (int m = 0; m < 4; ++m)
#pragma unroll
                for (int n = 0; n < 2; ++n) acc[a][b][m][n] = (f32x4){0.f, 0.f, 0.f, 0.f};
    bf16x8 At[4][2], B0[2][2], B1[2][2];
    const char* cA = (const char*)g.A + (size_t)cur.pm * tstep; const char* cB = (const char*)g.Bt + (size_t)cur.pn * tstep;
    S.a_ready(cur);
    if constexpr (SP2) {
        PG8_STAGE(PG8_SB(0, 0), cB, voffB); PG8_STAGE(PG8_SB(0, 1), cB + hstep, voffB); PG8_STAGE(PG8_SA(0, 0), cA, voffA); PG8_STAGE(PG8_SA(0, 1), cA + hstep, voffA);
        if (wr == 1) PG8_BAR;
        PG8_WAIT_V(2); PG8_BAR;
        PG8_STAGE(PG8_SB(1, 0), cB + kstep, voffB); PG8_STAGE(PG8_SA(1, 0), cA + kstep, voffA); PG8_STAGE(PG8_SB(1, 1), cB + hstep + kstep, voffB);
        PG8_WAIT_V(6); PG8_BAR;
    } else {
        PG8_STAGE(PG8_SB(0, 0), cB, voffB); PG8_STAGE(PG8_SA(0, 0), cA, voffA); PG8_STAGE(PG8_SB(0, 1), cB + hstep, voffB); PG8_STAGE(PG8_SA(0, 1), cA + hstep, voffA);
        if (wr == 1) PG8_BAR;
        PG8_WAIT_V(4); PG8_BAR;
        PG8_STAGE(PG8_SB(1, 0), cB + kstep, voffB); PG8_STAGE(PG8_SA(1, 0), cA + kstep, voffA); PG8_STAGE(PG8_SB(1, 1), cB + hstep + kstep, voffB);
        PG8_WAIT_V(6); PG8_BAR;
    }
    for (;;) {
        const bool has_next = S.next(ui + 1, nxt);
        const char* nA = has_next ? (const char*)g.A + (size_t)nxt.pm * tstep : cA; const char* nB = has_next ? (const char*)g.Bt + (size_t)nxt.pn * tstep : cB;
        for (int t = 0; t < nt; t += 2) {
            if (t == E.mid_t) E.mid(acc, cur, wr, wc, fr, fq);
            const bool last = (t == nt - 2);
            const char* a1 = cA + (size_t)(t + 1) * kstep;
            const char* a2 = last ? nA : cA + (size_t)(t + 2) * kstep; const char* b2 = last ? nB : cB + (size_t)(t + 2) * kstep;
            const char* a3 = a2 + kstep; const char* b3 = b2 + kstep;
            if (last && has_next) S.a_ready(nxt);
            if constexpr (SP2) {
            PG8_LDB(B0, 0, 0); PG8_LDB(B1, 0, 1); PG8_SCHED; PG8_LDA(At, 0, 0); PG8_STAGE(PG8_SA(1, 1), a1 + hstep, voffA);
            PG8_WAIT_V(8); PG8_WAIT_L(0); PG8_BAR; PG8_MMA(0, 0, At, B0); PG8_MMA(0, 1, At, B1); PG8_BAR; PG8_SCHED;
            PG8_LDA(At, 0, 1); PG8_STAGE(PG8_SB(0, 0), b2, voffB); PG8_STAGE(PG8_SB(0, 1), b2 + hstep, voffB); PG8_STAGE(PG8_SA(0, 0), a2, voffA);
            PG8_WAIT_V(8); PG8_WAIT_L(0); PG8_BAR; PG8_MMA(1, 0, At, B0); PG8_MMA(1, 1, At, B1); PG8_BAR; PG8_SCHED;
            PG8_LDB(B0, 1, 0); PG8_LDB(B1, 1, 1); PG8_SCHED; PG8_LDA(At, 1, 0); PG8_STAGE(PG8_SA(0, 1), a2 + hstep, voffA);
            PG8_WAIT_V(8); PG8_WAIT_L(0); PG8_BAR; PG8_MMA(0, 0, At, B0); PG8_MMA(0, 1, At, B1); PG8_BAR; PG8_SCHED;
            PG8_LDA(At, 1, 1); PG8_STAGE(PG8_SB(1, 0), b3, voffB); PG8_STAGE(PG8_SB(1, 1), b3 + hstep, voffB); PG8_STAGE(PG8_SA(1, 0), a3, voffA);
            PG8_WAIT_V(8); PG8_WAIT_L(0); PG8_BAR; PG8_MMA(1, 0, At, B0); PG8_MMA(1, 1, At, B1); PG8_BAR; PG8_SCHED;
            } else {
            PG8_LDB(B0, 0, 0); PG8_SCHED; PG8_LDA(At, 0, 0); PG8_STAGE(PG8_SA(1, 1), a1 + hstep, voffA);
            PG8_WAIT_L(8); PG8_BAR; PG8_WAIT_L(0); PG8_MMA(0, 0, At, B0); PG8_BAR; PG8_SCHED;
            PG8_LDB(B1, 0, 1); PG8_STAGE(PG8_SB(0, 0), b2, voffB);
            PG8_BAR; PG8_WAIT_L(0); PG8_MMA(0, 1, At, B1); PG8_BAR;
            PG8_LDA(At, 0, 1); PG8_STAGE(PG8_SA(0, 0), a2, voffA);
            PG8_BAR; PG8_WAIT_L(0); PG8_MMA(1, 0, At, B0); PG8_BAR; PG8_SCHED;
            PG8_STAGE(PG8_SB(0, 1), b2 + hstep, voffB);
            PG8_WAIT_V(6); PG8_BAR; PG8_MMA(1, 1, At, B1); PG8_BAR;
            PG8_LDB(B0, 1, 0); PG8_SCHED; PG8_LDA(At, 1, 0); PG8_STAGE(PG8_SA(0, 1), a2 + hstep, voffA);
            PG8_WAIT_L(8); PG8_BAR; PG8_WAIT_L(0); PG8_MMA(0, 0, At, B0); PG8_BAR; PG8_SCHED;
            PG8_LDB(B1, 1, 1); PG8_STAGE(PG8_SB(1, 0), b3, voffB);
            PG8_BAR; PG8_WAIT_L(0); PG8_MMA(0, 1, At, B1); PG8_BAR;
            PG8_LDA(At, 1, 1); PG8_STAGE(PG8_SA(1, 0), a3, voffA);
            PG8_BAR; PG8_WAIT_L(0); PG8_MMA(1, 0, At, B0); PG8_BAR; PG8_SCHED;
            PG8_STAGE(PG8_SB(1, 1), b3 + hstep, voffB);
            PG8_WAIT_V(6); PG8_BAR; PG8_MMA(1, 1, At, B1); PG8_BAR;
            }
        }
        if constexpr (ALIGN_EPI) { if (wr == 0) PG8_BAR; }
        if constexpr (!Epi::AFTER_DRAIN) { E(acc, cur, wr, wc, fr, fq); S.done(cur); }
        if (!has_next) break;
#pragma unroll
        for (int a = 0; a < 2; ++a)
#pragma unroll
            for (int b = 0; b < 2; ++b)
#pragma unroll
                for (int m = 0; m < 4; ++m)
#pragma unroll
                    for (int n = 0; n < 2; ++n) acc[a][b][m][n] = (f32x4){0.f, 0.f, 0.f, 0.f};
        cur = nxt; cA = nA; cB = nB; ++ui;
        if constexpr (ALIGN_EPI) { if (wr == 1) PG8_BAR; }
    }
    PG8_WAIT_V(0);
    if constexpr (!ALIGN_EPI) { if (wr == 0) PG8_BAR; }
    PG8_BAR;
    if constexpr (Epi::AFTER_DRAIN) { E.fused(acc, cur, wr, wc, fr, fq, lds, wid, lane); S.done(cur); }
#undef PG8_SA
#undef PG8_SB
#undef PG8_STAGE
#undef PG8_LDA
#undef PG8_LDB
#undef PG8_MMA
#undef PG8_WAIT_V
#undef PG8_WAIT_L
#undef PG8_BAR
#undef PG8_SCHED
}
}

using pg8::bf16_t; using pg8::f32x4; using pg8::u32x4; using pg8::bf16x8;
#define LAS __attribute__((address_space(3)))
typedef float f32x16 __attribute__((ext_vector_type(16)));
typedef short s16x4 __attribute__((ext_vector_type(4)));
typedef short v4i16_t __attribute__((ext_vector_type(4)));
typedef unsigned u32x2 __attribute__((ext_vector_type(2)));
typedef float f32x2_t __attribute__((ext_vector_type(2)));
typedef __bf16 bf16x2_t __attribute__((ext_vector_type(2)));

#ifndef REP_SUB
#define REP_SUB 0
#endif
#ifndef REP_N
#define REP_N 1
#endif
#ifndef SYNC_N
#define SYNC_N 1
#endif
#ifndef H_STORE_BITS
#define H_STORE_BITS "sc0 sc1"
#endif
#ifndef MK_MULTI
#define MK_MULTI 0
#endif

constexpr int BATCH = 16, SEQ = 2048, DM = 1024, MTOK = BATCH * SEQ, FF = 2816, NUP = 2 * FF, NIN = 5888, DEPTH = 2;
constexpr float RMS_EPS = 1e-6f, LOG2E = 1.4426950408889634f, QSCALE = 0.125f * 1.4426950408889634f;
constexpr int NPH = DEPTH * 10 + 1;
constexpr int NTHREADS = 512, NWAVES = 8;
constexpr int LDS_BYTES = 131072 + 1024;

constexpr size_t MiB = 1u << 20;
constexpr size_t WS_CTL = 0, CTL_ZERO_BYTES = 65536;
constexpr size_t WS_ROPE = 1 * MiB;
constexpr size_t WS_SSQ = 2 * MiB;
constexpr size_t WS_LSE = 4 * MiB;
constexpr size_t WS_W = 8 * MiB;
constexpr size_t W_UP1 = 0, W_DOWN1 = 11 * MiB, W_IN = W_DOWN1 + 11 * MiB / 2, W_PA = 28 * MiB, W_PB = W_PA + MiB / 2, W_OUT = W_PB + MiB, W_UP2 = W_OUT + 2 * MiB, W_DOWN2 = W_UP2 + 11 * MiB;
static_assert(W_IN + (size_t)NIN * DM * 2 == W_PA && W_DOWN2 + (size_t)DM * FF * 2 == 48 * MiB, "weight map");
constexpr size_t WS_XB = 56 * MiB;
constexpr size_t WS_R = 120 * MiB;
constexpr size_t R_H = 0;
constexpr size_t R_QA = 0, R_KA = 48 * MiB, R_VA = 96 * MiB, R_QB = 144 * MiB, R_KB = 176 * MiB, R_VB = 208 * MiB, R_GA = 240 * MiB, R_GB = 304 * MiB, R_YA = 368 * MiB, R_YB = R_KA, R_END = 384 * MiB;
constexpr size_t WS_NEED = WS_R + R_END;

struct Args { const float* in[14]; float* out; unsigned char* ws; int ph_lo, ph_hi; };

__device__ __forceinline__ unsigned pk2(float lo, float hi) { f32x2_t v = {lo, hi}; bf16x2_t b = __builtin_convertvector(v, bf16x2_t); return __builtin_bit_cast(unsigned, b); }
__device__ __forceinline__ float bf_lo(unsigned u) { return __uint_as_float(u << 16); }
__device__ __forceinline__ float bf_hi(unsigned u) { return __uint_as_float(u & 0xffff0000u); }
__device__ __forceinline__ float fast_sigmoid(float z) { return __builtin_amdgcn_rcpf(1.0f + __expf(-z)); }

__device__ __forceinline__ float row_rs(const float* ssq, unsigned row, int fq) {
    const f32x4 p = *(const f32x4*)(ssq + (row * 16u + fq * 4));
    float s = (p[0] + p[1]) + (p[2] + p[3]);
    s += __shfl_xor(s, 16); s += __shfl_xor(s, 32);
    return rsqrtf(s * (1.0f / 1024.0f) + RMS_EPS);
}

__device__ __forceinline__ void load_rs8(const float* ssq, unsigned row0, int fq, float (&rs)[8]) {
    f32x4 p[8];
#pragma unroll
    for (int k = 0; k < 8; ++k) p[k] = *(const f32x4*)(ssq + ((row0 + (k >> 2) * 128 + (k & 3) * 16) * 16u + fq * 4));
#pragma unroll
    for (int k = 0; k < 8; ++k) { float s = (p[k][0] + p[k][1]) + (p[k][2] + p[k][3]); s += __shfl_xor(s, 16); s += __shfl_xor(s, 32); rs[k] = rsqrtf(s * (1.0f / 1024.0f) + RMS_EPS); }
}
struct EpiAny {
    static constexpr bool PERM = true, AFTER_DRAIN = false;
    int kind; int mid_t; float alpha; unsigned char* R; bf16_t* xb; float* ssq; const float* ropec;
    __device__ __forceinline__ void mid(f32x4 (&acc)[2][2][4][2], const pg8::Unit& u, int wr, int wc, int fr, int fq) const {
        const bf16_t* GA = (const bf16_t*)(R + R_GA); const bf16_t* GB = (const bf16_t*)(R + R_GB);
        unsigned row0 = u.pm * 256 + wr * 64 + fr; asm volatile("" : "+v"(row0));
        const unsigned col0 = u.pn * 256 + wc * 32 + 8 * fq;
#pragma unroll
        for (int ai = 0; ai < 2; ++ai) {
            u32x4 tv[4][2], gv[4][2];
#pragma unroll
            for (int m = 0; m < 4; ++m)
#pragma unroll
                for (int bj = 0; bj < 2; ++bj) { const unsigned off = (row0 + ai * 128 + m * 16) * (unsigned)DM + col0 + bj * 128; tv[m][bj] = *(const u32x4*)(GA + off); gv[m][bj] = *(const u32x4*)(GB + off); }
#pragma unroll
            for (int m = 0; m < 4; ++m)
#pragma unroll
                for (int bj = 0; bj < 2; ++bj)
#pragma unroll
                    for (int n = 0; n < 2; ++n)
#pragma unroll
                        for (int i = 0; i < 2; ++i) {
                            const unsigned ta = tv[m][bj][2 * n + i], tb = gv[m][bj][2 * n + i];
                            acc[ai][bj][m][n][2 * i] *= bf_lo(ta) * __builtin_amdgcn_rcpf(fmaxf(bf_lo(tb), 1e-30f));
                            acc[ai][bj][m][n][2 * i + 1] *= bf_hi(ta) * __builtin_amdgcn_rcpf(fmaxf(bf_hi(tb), 1e-30f));
                        }
            asm volatile("" ::: "memory");
        }
    }
    __device__ __forceinline__ void operator()(const f32x4 (&acc)[2][2][4][2], const pg8::Unit& u, int wr, int wc, int fr, int fq) const {
        const unsigned row0 = u.pm * 256 + wr * 64 + fr;
        if (kind == 0) {
            bf16_t* H = (bf16_t*)(R + R_H); const unsigned col0 = u.pn * 128 + wc * 32 + 8 * fq;
            float rs8[8]; load_rs8(ssq, row0, fq, rs8);
#pragma unroll
            for (int ai = 0; ai < 2; ++ai)
#pragma unroll
                for (int m = 0; m < 4; ++m) {
                    const unsigned row = row0 + ai * 128 + m * 16; const float rs = rs8[ai * 4 + m];
                    u32x4 w;
#pragma unroll
                    for (int n = 0; n < 2; ++n) {
                        const f32x4 g = acc[ai][0][m][n] * rs, up = acc[ai][1][m][n] * rs; f32x4 hh;
#pragma unroll
                        for (int i = 0; i < 4; ++i) hh[i] = g[i] * fast_sigmoid(g[i]) * up[i];
                        w[2 * n] = pk2(hh[0], hh[1]); w[2 * n + 1] = pk2(hh[2], hh[3]);
                    }
                    { bf16_t* hp_ = H + (row * (unsigned)FF + col0); asm volatile("global_store_dwordx4 %0, %1, off " H_STORE_BITS "\n\ts_nop 1" :: "v"(hp_), "v"(w) : "memory"); }
                }
        } else if (kind == 1) {
            const unsigned col0 = u.pn * 256 + wc * 32 + 8 * fq;
#pragma unroll
            for (int hb = 0; hb < 2; ++hb) { const int ai = hb;
                u32x4 bv[4][2];
#pragma unroll
                for (int m = 0; m < 4; ++m)
#pragma unroll
                    for (int bj = 0; bj < 2; ++bj) { const unsigned off = (row0 + ai * 128 + m * 16) * (unsigned)DM + col0 + bj * 128; bv[m][bj] = *(const u32x4*)(xb + off); }
#pragma unroll
                for (int m = 0; m < 4; ++m) {
                    const unsigned row = row0 + ai * 128 + m * 16; float sq = 0.f;
#pragma unroll
                    for (int bj = 0; bj < 2; ++bj) {
                        const unsigned off = row * (unsigned)DM + col0 + bj * 128; const u32x4 b = bv[m][bj];
                        f32x4 v0, v1;
                        v0[0] = bf_lo(b[0]); v0[1] = bf_hi(b[0]); v0[2] = bf_lo(b[1]); v0[3] = bf_hi(b[1]); v1[0] = bf_lo(b[2]); v1[1] = bf_hi(b[2]); v1[2] = bf_lo(b[3]); v1[3] = bf_hi(b[3]);
                        v0 = v0 + acc[ai][bj][m][0] * alpha; v1 = v1 + acc[ai][bj][m][1] * alpha;
                        u32x4 w; w[0] = pk2(v0[0], v0[1]); w[1] = pk2(v0[2], v0[3]); w[2] = pk2(v1[0], v1[1]); w[3] = pk2(v1[2], v1[3]);
                        { bf16_t* xp_ = xb + off; asm volatile("global_store_dwordx4 %0, %1, off sc0 sc1\n\ts_nop 1" :: "v"(xp_), "v"(w) : "memory"); }
                        sq += (v0[0] * v0[0] + v0[1] * v0[1]) + (v0[2] * v0[2] + v0[3] * v0[3]) + (v1[0] * v1[0] + v1[1] * v1[1]) + (v1[2] * v1[2] + v1[3] * v1[3]);
                    }
                    sq += __shfl_xor(sq, 16); sq += __shfl_xor(sq, 32);
                    if (fq == 0) ssq[row * 16u + u.pn * 4 + wc] = sq;
                }
                asm volatile("" ::: "memory");
            }
        } else if (kind == 2) {
            const int pn = u.pn; size_t boff; unsigned ld, pl; int mode; float sc = 1.f;
            if (pn < 3) { boff = R_QA; ld = 768; pl = pn; mode = 1; sc = QSCALE; }
            else if (pn < 6) { boff = R_KA; ld = 768; pl = pn - 3; mode = 1; }
            else if (pn < 9) { boff = R_VA; ld = 768; pl = pn - 6; mode = 0; }
            else if (pn < 11) { boff = R_QB; ld = 512; pl = pn - 9; mode = 0; sc = QSCALE; }
            else if (pn < 13) { boff = R_KB; ld = 512; pl = pn - 11; mode = 0; }
            else if (pn < 15) { boff = R_VB; ld = 512; pl = pn - 13; mode = 0; }
            else if (pn < 19) { boff = R_GA; ld = 1024; pl = pn - 15; mode = 2; }
            else { boff = R_GB; ld = 1024; pl = pn - 19; mode = 2; }
            bf16_t* ob = (bf16_t*)(R + boff);
            float rs8[8]; load_rs8(ssq, row0, fq, rs8);
            if (mode == 1) {
                const unsigned colo = (4 * pl + wc) * 64 + 8 * fq; const float* ropes = ropec + SEQ * 32;
#pragma unroll
                for (int hb = 0; hb < 4; ++hb) { const int ai = hb >> 1, mb = 2 * (hb & 1);
                    f32x4 cv[4][2], sv[4][2];
#pragma unroll
                    for (int m = mb; m < mb + 2; ++m)
#pragma unroll
                        for (int n = 0; n < 2; ++n) { const unsigned ro = ((row0 + ai * 128 + m * 16) & (SEQ - 1)) * 32 + 8 * fq + 4 * n; cv[m][n] = *(const f32x4*)(ropec + ro); sv[m][n] = *(const f32x4*)(ropes + ro); }
#pragma unroll
                    for (int m = mb; m < mb + 2; ++m) {
                        const unsigned row = row0 + ai * 128 + m * 16; const float rs = rs8[ai * 4 + m];
                        u32x4 w1, w2;
#pragma unroll
                        for (int n = 0; n < 2; ++n) {
                            const f32x4 c = cv[m][n], s = sv[m][n];
                            const f32x4 t1 = acc[ai][0][m][n] * rs, t2 = acc[ai][1][m][n] * rs;
                            const f32x4 o1 = (t1 * c - t2 * s) * sc, o2 = (t2 * c + t1 * s) * sc;
                            w1[2 * n] = pk2(o1[0], o1[1]); w1[2 * n + 1] = pk2(o1[2], o1[3]); w2[2 * n] = pk2(o2[0], o2[1]); w2[2 * n + 1] = pk2(o2[2], o2[3]);
                        }
                        const unsigned off = row * 768u + colo;
                        *(u32x4*)(ob + off) = w1; *(u32x4*)(ob + off + 32) = w2;
                    }
                    asm volatile("" ::: "memory");
                }
            } else {
                const unsigned colo = pl * 256 + wc * 32 + 8 * fq;
#pragma unroll
                for (int ai = 0; ai < 2; ++ai)
#pragma unroll
                    for (int m = 0; m < 4; ++m) {
                        const unsigned row = row0 + ai * 128 + m * 16; const float f = rs8[ai * 4 + m] * sc;
#pragma unroll
                        for (int bj = 0; bj < 2; ++bj) {
                            f32x4 v0 = acc[ai][bj][m][0] * f, v1 = acc[ai][bj][m][1] * f;
                            if (mode == 2) {
#pragma unroll
                                for (int i = 0; i < 4; ++i) { v0[i] = fast_sigmoid(v0[i]); v1[i] = fast_sigmoid(v1[i]); }
                            }
                            u32x4 w; w[0] = pk2(v0[0], v0[1]); w[1] = pk2(v0[2], v0[3]); w[2] = pk2(v1[0], v1[1]); w[3] = pk2(v1[2], v1[3]);
                            *(u32x4*)(ob + (row * ld + colo + bj * 128)) = w;
                        }
                    }
            }
        } else {
            bf16_t* GA = (bf16_t*)(R + R_GA); const bf16_t* GB = (const bf16_t*)(R + R_GB);
            const unsigned col0 = u.pn * 256 + wc * 32 + 8 * fq;
#pragma unroll
            for (int hb = 0; hb < 2; ++hb) { const int ai = hb, mb = 0;
                u32x4 gv[4][2];
#pragma unroll
                for (int m = mb; m < mb + 4; ++m)
#pragma unroll
                    for (int bj = 0; bj < 2; ++bj) { const unsigned off = (row0 + ai * 128 + m * 16) * (unsigned)DM + col0 + bj * 128; gv[m][bj] = *(const u32x4*)(GB + off); }
#pragma unroll
                for (int m = mb; m < mb + 4; ++m)
#pragma unroll
                    for (int bj = 0; bj < 2; ++bj) {
                        const unsigned off = (row0 + ai * 128 + m * 16) * (unsigned)DM + col0 + bj * 128;
                        const u32x4 g = gv[m][bj]; const f32x4 a0 = acc[ai][bj][m][0], a1 = acc[ai][bj][m][1]; u32x4 w;
                        w[0] = pk2(bf_lo(g[0]) * a0[0], bf_hi(g[0]) * a0[1]); w[1] = pk2(bf_lo(g[1]) * a0[2], bf_hi(g[1]) * a0[3]);
                        w[2] = pk2(bf_lo(g[2]) * a1[0], bf_hi(g[2]) * a1[1]); w[3] = pk2(bf_lo(g[3]) * a1[2], bf_hi(g[3]) * a1[3]);
                        *(u32x4*)(GA + off) = w;
                    }
                asm volatile("" ::: "memory");
            }
        }
    }
};

__device__ __forceinline__ int crow(int r, int hi) { return (r & 3) + 8 * (r >> 2) + 4 * hi; }
__device__ __forceinline__ s16x4 vtr(LAS unsigned char* p) { return __builtin_bit_cast(s16x4, __builtin_amdgcn_ds_read_tr16_b64_v4i16((LAS v4i16_t*)p)); }
#define CBAR() asm volatile("" ::: "memory")

__device__ __forceinline__ void v_tile_store(LAS unsigned char* vl, const u32x4 (&vc)[4], int lane) {
    const int dc = lane & 7;
#pragma unroll
    for (int i = 0; i < 4; ++i) { const int key = (lane >> 3) + 8 * i; *(LAS u32x4*)(vl + (dc >> 2) * 2048 + key * 64 + (dc & 3) * 16) = vc[i]; }
}
__device__ __forceinline__ void k_tile_store(LAS unsigned char* kl, const u32x4 (&kc)[4], int lane) {
#pragma unroll
    for (int i = 0; i < 4; ++i) *(LAS u32x4*)(kl + ((lane >> 3) + 8 * i) * 144 + (lane & 7) * 16) = kc[i];
}
__device__ __forceinline__ void k_frag_load(LAS unsigned char* kl, bf16x8 (&kf)[4], int lane) {
#pragma unroll
    for (int s = 0; s < 4; ++s) kf[s] = *(const LAS bf16x8*)(kl + (lane & 31) * 144 + s * 32 + (lane >> 5) * 16);
}
__device__ __forceinline__ void softmax_pv(f32x16& s, float& m, float& l, f32x16& o0, f32x16& o1, LAS unsigned char* vl, int lane) {
    const int hi = lane >> 5;
    float mx = s[0];
#pragma unroll
    for (int r = 1; r < 16; ++r) mx = fmaxf(mx, s[r]);
    mx = fmaxf(mx, __shfl_xor(mx, 32));
    if (__any(mx > m + 8.0f)) {
        const float mn = fmaxf(m, mx), alpha = __builtin_amdgcn_exp2f(m - mn);
        m = mn; l *= alpha;
#pragma unroll
        for (int r = 0; r < 16; ++r) { o0[r] *= alpha; o1[r] *= alpha; }
    }
    float sum = 0.f;
#pragma unroll
    for (int r = 0; r < 16; ++r) { s[r] = __builtin_amdgcn_exp2f(s[r] - m); sum += s[r]; }
    l += sum;
    u32x4 p0, p1;
#pragma unroll
    for (int i = 0; i < 4; ++i) { p0[i] = pk2(s[2 * i], s[2 * i + 1]); p1[i] = pk2(s[8 + 2 * i], s[8 + 2 * i + 1]); }
    const bf16x8 pb0 = __builtin_bit_cast(bf16x8, p0), pb1 = __builtin_bit_cast(bf16x8, p1);
    LAS unsigned char* vb = vl + (4 * hi + ((lane & 15) >> 2)) * 64 + (16 * ((lane >> 4) & 1) + 4 * (lane & 3)) * 2;
#pragma unroll
    for (int dt = 0; dt < 2; ++dt) {
#pragma unroll
        for (int ks = 0; ks < 2; ++ks) {
            const s16x4 lo = vtr(vb + dt * 2048 + ks * 1024), hh = vtr(vb + dt * 2048 + ks * 1024 + 512);
            const bf16x8 vf = (bf16x8){lo[0], lo[1], lo[2], lo[3], hh[0], hh[1], hh[2], hh[3]};
            if (dt == 0) o0 = __builtin_amdgcn_mfma_f32_32x32x16_bf16(vf, ks == 0 ? pb0 : pb1, o0, 0, 0, 0);
            else         o1 = __builtin_amdgcn_mfma_f32_32x32x16_bf16(vf, ks == 0 ? pb0 : pb1, o1, 0, 0, 0);
        }
    }
}
__device__ __forceinline__ void attn_store(bf16_t* orow, const f32x16& o0, const f32x16& o1, float inv, int hi) {
#pragma unroll
    for (int g = 0; g < 4; ++g) {
        u32x2 w0, w1;
        w0[0] = pk2(o0[4 * g] * inv, o0[4 * g + 1] * inv); w0[1] = pk2(o0[4 * g + 2] * inv, o0[4 * g + 3] * inv);
        w1[0] = pk2(o1[4 * g] * inv, o1[4 * g + 1] * inv); w1[1] = pk2(o1[4 * g + 2] * inv, o1[4 * g + 3] * inv);
        *(u32x2*)(orow + 8 * g + 4 * hi) = w0; *(u32x2*)(orow + 32 + 8 * g + 4 * hi) = w1;
    }
}

__device__ __forceinline__ void attnA_phase(const bf16_t* QA, bf16_t* OA, const bf16_t* KA, const bf16_t* VA, float* LSE, LAS unsigned char* lds, int gw, int ngw, int lane, int wave) {
    LAS unsigned char* vl = lds + wave * 16384;
    const int q = lane & 31, hi = lane >> 5;
    for (int it = gw; it < BATCH * 12 * 64; it += ngw) {
        const int b = it / 768, rem = it % 768, h = rem >> 6, qt = rem & 63;
        const int dsh = 2 * (h >> 2), tpr = 64 >> dsh, rho = qt >> (6 - dsh), lt = qt & (tpr - 1);
        const size_t rowb = (size_t)b * SEQ;
        const int tq = ((lt * 32 + q) << dsh) + rho;
        const bf16_t* Qp = QA + (rowb + tq) * 768 + h * 64;
        bf16x8 qf[4];
#pragma unroll
        for (int s = 0; s < 4; ++s) qf[s] = *(const bf16x8*)(Qp + 16 * s + 8 * hi);
        const int k_lo = lt - 2 < 0 ? 0 : lt - 2, k_hi = lt + 2 > tpr - 1 ? tpr - 1 : lt + 2;
        float m = -1e30f, l = 0.f; f32x16 o0 = {}, o1 = {};
        bf16x8 kf[4]; u32x4 vc[4], kc[4]; LAS unsigned char* kl = vl + 8192;
#pragma unroll
        for (int i = 0; i < 4; ++i) { const int tv = ((k_lo * 32 + (lane >> 3) + 8 * i) << dsh) + rho; const size_t o_ = (rowb + tv) * 768 + h * 64 + (lane & 7) * 8; kc[i] = *(const u32x4*)(KA + o_); vc[i] = *(const u32x4*)(VA + o_); }
        for (int kt = k_lo; kt <= k_hi; ++kt) {
            CBAR(); v_tile_store(vl, vc, lane); k_tile_store(kl, kc, lane); CBAR();
            k_frag_load(kl, kf, lane); CBAR();
            if (kt < k_hi) {
#pragma unroll
                for (int i = 0; i < 4; ++i) { const int tv = (((kt + 1) * 32 + (lane >> 3) + 8 * i) << dsh) + rho; const size_t o_ = (rowb + tv) * 768 + h * 64 + (lane & 7) * 8; kc[i] = *(const u32x4*)(KA + o_); vc[i] = *(const u32x4*)(VA + o_); }
            }
            f32x16 s = {};
#pragma unroll
            for (int ss = 0; ss < 4; ++ss) s = __builtin_amdgcn_mfma_f32_32x32x16_bf16(kf[ss], qf[ss], s, 0, 0, 0);
            const int dk = kt - lt;
            if (dk == -2) {
#pragma unroll
                for (int r = 0; r < 16; ++r) if (crow(r, hi) < q) s[r] = -INFINITY;
            } else if (dk == 2) {
#pragma unroll
                for (int r = 0; r < 16; ++r) if (crow(r, hi) > q) s[r] = -INFINITY;
            }
            softmax_pv(s, m, l, o0, o1, vl, lane);
        }
        const float lt_ = l + __shfl_xor(l, 32), inv = 1.0f / lt_;
        attn_store(OA + (rowb + tq) * 768 + h * 64, o0, o1, inv, hi);
        if (hi == 0) LSE[(rowb + tq) * 12 + h] = m + __builtin_amdgcn_logf(lt_);
    }
}

__device__ __forceinline__ void attnB_phase(const bf16_t* QB, const bf16_t* KB, const bf16_t* VB, bf16_t* YB, const float* relb, LAS unsigned char* lds, int gw, int ngw, int lane, int wave) {
    LAS unsigned char* vl = lds + wave * 16384; LAS float* bl = (LAS float*)(vl + 4096);
    const int q = lane & 31, hi = lane >> 5; int h_loaded = -1;
    for (int it = gw; it < BATCH * 8 * 64; it += ngw) {
        const int b = it >> 9, rem = it & 511, h = rem >> 6, rp = (rem >> 2) & 15, cb = rem & 3;
        const int q_row = 2 * rp + (q >> 4), q_col = 16 * cb + (q & 15), tq = q_row * 64 + q_col;
        int kc0 = 16 * cb - 8; kc0 = kc0 < 0 ? 0 : (kc0 > 32 ? 32 : kc0);
        int lo0 = 2 * rp - 4; lo0 = lo0 < 0 ? 0 : (lo0 > 24 ? 24 : lo0);
        int lo1 = 2 * rp - 3; lo1 = lo1 < 0 ? 0 : (lo1 > 24 ? 24 : lo1);
        const int ntile = lo1 + 8 - lo0;
        int my_lo = q_row - 4; my_lo = my_lo < 0 ? 0 : (my_lo > 24 ? 24 : my_lo);
        int win_lo = q_col - 8; win_lo = win_lo < 0 ? 0 : (win_lo > 48 ? 48 : win_lo);
        const size_t rowb = (size_t)b * SEQ;
        if (h != h_loaded) {
            CBAR();
            for (int i = lane; i < 16 * 64; i += 64) { const int rr = i >> 6, c = i & 63; float v = rr == 15 ? -INFINITY : 0.f; if (rr < 15 && c >= 16 && c < 47) v = relb[h * 465 + rr * 31 + (c - 16)] * LOG2E; bl[i] = v; }
            CBAR(); h_loaded = h;
        }
        const bf16_t* Qp = QB + (rowb + tq) * 512 + h * 64;
        bf16x8 qf[4];
#pragma unroll
        for (int s = 0; s < 4; ++s) qf[s] = *(const bf16x8*)(Qp + 16 * s + 8 * hi);
        float m = -1e30f, l = 0.f; f32x16 o0 = {}, o1 = {};
        bf16x8 kf[4]; u32x4 vc[4], kc[4]; LAS unsigned char* kl = vl + 8192;
        const int cbase = kc0 + 4 * hi - q_col + 15;
        const int kcb = kc0 + 4 * hi;
        f32x16 cinit;
#pragma unroll
        for (int r = 0; r < 16; ++r) { const int kcol = kcb + (r & 3) + 8 * (r >> 2); cinit[r] = (kcol >= win_lo && kcol < win_lo + 16) ? 0.f : -INFINITY; }
#pragma unroll
        for (int i = 0; i < 4; ++i) { const size_t o_ = (rowb + lo0 * 64 + kc0 + (lane >> 3) + 8 * i) * 512 + h * 64 + (lane & 7) * 8; kc[i] = *(const u32x4*)(KB + o_); vc[i] = *(const u32x4*)(VB + o_); }
        for (int j = 0; j < ntile; ++j) {
            const int key_row = lo0 + j;
            CBAR(); v_tile_store(vl, vc, lane); k_tile_store(kl, kc, lane); CBAR();
            k_frag_load(kl, kf, lane); CBAR();
            if (j + 1 < ntile) {
#pragma unroll
                for (int i = 0; i < 4; ++i) { const size_t o_ = (rowb + (key_row + 1) * 64 + kc0 + (lane >> 3) + 8 * i) * 512 + h * 64 + (lane & 7) * 8; kc[i] = *(const u32x4*)(KB + o_); vc[i] = *(const u32x4*)(VB + o_); }
            }
            f32x16 s = cinit;
#pragma unroll
            for (int ss = 0; ss < 4; ++ss) s = __builtin_amdgcn_mfma_f32_32x32x16_bf16(kf[ss], qf[ss], s, 0, 0, 0);
            const bool row_ok = key_row >= my_lo && key_row < my_lo + 8;
            const LAS float* bp = bl + (row_ok ? key_row - q_row + 7 : 15) * 64 + 16 + cbase;
#pragma unroll
            for (int r = 0; r < 16; ++r) s[r] += bp[(r & 3) + 8 * (r >> 2)];
            softmax_pv(s, m, l, o0, o1, vl, lane);
        }
        const float lt_ = l + __shfl_xor(l, 32), inv = 1.0f / lt_;
        attn_store(YB + (rowb + tq) * 768 + 256 + h * 64, o0, o1, inv, hi);
    }
}

__device__ __forceinline__ void mix_phase(const bf16_t* OA, const float* LSE, bf16_t* YA, int gtid, int nthr) {
    for (int idx = gtid; idx < MTOK * 32; idx += nthr) {
        const int t = idx >> 5, j = (idx >> 3) & 3, dc = idx & 7;
        const float l0 = LSE[(size_t)t * 12 + j], l1 = LSE[(size_t)t * 12 + 4 + j], l2 = LSE[(size_t)t * 12 + 8 + j];
        const float mx = fmaxf(l0, fmaxf(l1, l2));
        float w0 = __builtin_amdgcn_exp2f(l0 - mx), w1 = __builtin_amdgcn_exp2f(l1 - mx), w2 = __builtin_amdgcn_exp2f(l2 - mx);
        const float inv = 1.0f / (w0 + w1 + w2); w0 *= inv; w1 *= inv; w2 *= inv;
        const bf16_t* p = OA + (size_t)t * 768 + j * 64 + dc * 8;
        const u32x4 a = *(const u32x4*)p, bb = *(const u32x4*)(p + 256), c = *(const u32x4*)(p + 512);
        u32x4 w;
#pragma unroll
        for (int i = 0; i < 4; ++i) w[i] = pk2(w0 * bf_lo(a[i]) + w1 * bf_lo(bb[i]) + w2 * bf_lo(c[i]), w0 * bf_hi(a[i]) + w1 * bf_hi(bb[i]) + w2 * bf_hi(c[i]));
        *(u32x4*)(YA + (size_t)t * 768 + j * 64 + dc * 8) = w;
    }
}

__device__ __forceinline__ int srcmap(int type, int n) {
    if (type == 1) { const int pn = n >> 8, bj = (n >> 7) & 1, jj = n & 127; return bj * FF + 128 * pn + jj; }
    if (type == 2 && n < 1536) { const int base = n >= 768 ? 768 : 0, loc = n - base, tile = loc >> 8, c = loc & 255; return base + (4 * tile + ((c >> 5) & 3)) * 64 + 32 * (c >> 7) + (c & 31); }
    return n;
}
struct ConvDesc { const float* W; bf16_t* WT; const float* gain; int K, N, type, item, ldk; };
__device__ __forceinline__ void conv_load(const ConvDesc& c, int lane, f32x4 (&r)[4], unsigned& dst) {
    const int nblk = c.N >> 4, kb = c.item / nblk, nb = c.item - kb * nblk, k0 = 64 * kb, n0 = 16 * nb, lk = lane & 15, ln = lane >> 4;
    const float* p = c.W + (size_t)(k0 + 4 * lk) * c.N + srcmap(c.type, n0) + 4 * ln;
#pragma unroll
    for (int i = 0; i < 4; ++i) r[i] = __builtin_nontemporal_load((const f32x4*)(p + (size_t)i * c.N));
    if (c.gain) { const f32x4 g = *(const f32x4*)(c.gain + k0 + 4 * lk);
#pragma unroll
        for (int i = 0; i < 4; ++i) r[i] = r[i] * g[i]; }
    dst = (unsigned)(n0 + 4 * ln) * (unsigned)c.ldk + k0 + 4 * lk;
}
__device__ __forceinline__ void conv_store(const ConvDesc& c, const f32x4 (&r)[4], unsigned dst) {
#pragma unroll
    for (int j = 0; j < 4; ++j) { u32x2 w; w[0] = pk2(r[0][j], r[1][j]); w[1] = pk2(r[2][j], r[3][j]); *(u32x2*)(c.WT + (dst + (unsigned)j * (unsigned)c.ldk)) = w; }
}
__device__ __forceinline__ ConvDesc conv_desc(const Args& a, bf16_t* wb, int L, int it) {
    ConvDesc c; int r = it; c.gain = nullptr; c.type = 0;
    if (r < 5632) { c.W = a.in[2] + (size_t)L * DM * NUP; c.K = DM; c.N = NUP; c.WT = (bf16_t*)((unsigned char*)wb + W_UP1); c.gain = a.in[1] + L * DM; c.type = 1; c.item = r; c.ldk = c.K; return c; } r -= 5632;
    if (r < 2816) { c.W = a.in[3] + (size_t)L * FF * DM; c.K = FF; c.N = DM; c.WT = (bf16_t*)((unsigned char*)wb + W_DOWN1); c.item = r; c.ldk = c.K; return c; } r -= 2816;
    if (r < 5888) { c.W = a.in[5] + (size_t)L * DM * NIN; c.K = DM; c.N = NIN; c.WT = (bf16_t*)((unsigned char*)wb + W_IN); c.gain = a.in[4] + L * DM; c.type = 2; c.item = r; c.ldk = c.K; return c; } r -= 5888;
    if (r < 256) { c.W = a.in[7] + (size_t)L * 256 * DM; c.K = 256; c.N = DM; c.WT = (bf16_t*)((unsigned char*)wb + W_PA); c.item = r; c.ldk = 768; return c; } r -= 256;
    if (r < 512) { c.W = a.in[8] + (size_t)L * 512 * DM; c.K = 512; c.N = DM; c.WT = (bf16_t*)((unsigned char*)wb + W_PA) + 256; c.item = r; c.ldk = 768; return c; } r -= 512;
    if (r < 1024) { c.W = a.in[9] + (size_t)L * DM * DM; c.K = DM; c.N = DM; c.WT = (bf16_t*)((unsigned char*)wb + W_OUT); c.item = r; c.ldk = c.K; return c; } r -= 1024;
    if (r < 5632) { c.W = a.in[11] + (size_t)L * DM * NUP; c.K = DM; c.N = NUP; c.WT = (bf16_t*)((unsigned char*)wb + W_UP2); c.gain = a.in[10] + L * DM; c.type = 1; c.item = r; c.ldk = c.K; return c; } r -= 5632;
    c.W = a.in[12] + (size_t)L * FF * DM; c.K = FF; c.N = DM; c.WT = (bf16_t*)((unsigned char*)wb + W_DOWN2); c.item = r; c.ldk = c.K; return c;
}
__device__ __forceinline__ float wave_sum(float v) {
#pragma unroll
    for (int o = 1; o < 64; o <<= 1) v += __shfl_xor(v, o);
    return v;
}

typedef unsigned gu32_t;
#define XB_TMO      128
#define XB_XCNT(j)  (256  + 64 * (j))
#define XB_XSUB(j)  (1280 + 64 * (j))
#define XB_XGEN(j)  (2304 + 64 * (j))
#define XB_TOP      3328
#define XB_TOPGEN   3392
#define XCD_BAR_WORDS 3456
#define XB_SPIN_CAP (1u << 18)

__device__ __forceinline__ unsigned xb_ld(unsigned* p)              { return __hip_atomic_load(p, __ATOMIC_RELAXED, __HIP_MEMORY_SCOPE_AGENT); }
__device__ __forceinline__ unsigned xb_add(unsigned* p, unsigned v) { return __hip_atomic_fetch_add(p, v, __ATOMIC_RELAXED, __HIP_MEMORY_SCOPE_AGENT); }
__device__ __forceinline__ unsigned xb_xcc_id() { return (unsigned)__builtin_amdgcn_s_getreg((3 << 11) | 20) & 0xFu; }
#define XB_SPIN(cond, bar) do { unsigned _sp = 0; while (cond) { __builtin_amdgcn_s_sleep(1); \
    if ((++_sp & 255u) == 0u) { if (xb_ld(&(bar)[XB_TMO])) break; if (_sp > XB_SPIN_CAP) { atomicAdd(&(bar)[XB_TMO], 1u); break; } } } } while (0)

struct XcdBarrier {
    unsigned* bar; unsigned x;
    volatile LAS unsigned* st;
};

__device__ __forceinline__ XcdBarrier xcd_barrier_post(unsigned* bar, volatile LAS unsigned* st) {
    XcdBarrier b; b.bar = bar; b.x = xb_xcc_id(); b.st = st;
    if (threadIdx.x == 0) (void)xb_add(&bar[XB_XCNT(b.x)], 1u);
    return b;
}
__device__ __forceinline__ void xcd_barrier_complete(unsigned* bar, unsigned x, unsigned& nloc, unsigned& nx) {
    const unsigned G = gridDim.x * gridDim.y * gridDim.z;
    unsigned sum, cnt, mine, sp = 0u;
    for (;;) {
        sum = 0u; cnt = 0u; mine = 0u;
#pragma unroll
        for (unsigned j = 0; j < 16; ++j) { const unsigned c = xb_ld(&bar[XB_XCNT(j)]); sum += c; cnt += (c > 0u) ? 1u : 0u; mine = (j == x) ? c : mine; }
        if (sum == G) break;
        __builtin_amdgcn_s_sleep(1);
        if ((++sp & 255u) == 0u) { if (xb_ld(&bar[XB_TMO])) break; if (sp > XB_SPIN_CAP) { atomicAdd(&bar[XB_TMO], 1u); break; } }
    }
    nloc = mine > 0u ? mine : 1u; nx = cnt > 0u ? cnt : 1u;
}

__device__ __forceinline__ void xcd_barrier(const XcdBarrier& b) {
    asm volatile("s_waitcnt vmcnt(0)" ::: "memory");
    __syncthreads();
    if (threadIdx.x == 0) {
        unsigned* bar = b.bar;
        __builtin_amdgcn_s_waitcnt(0);
        unsigned nloc = b.st[0], nx = b.st[1];
        if (nloc == 0u) { xcd_barrier_complete(bar, b.x, nloc, nx); b.st[0] = nloc; b.st[1] = nx; }
        const unsigned old = xb_add(&bar[XB_XSUB(b.x)], 1u);
        const unsigned gen = old / nloc;
        if (old + 1u == (gen + 1u) * nloc) {
            __builtin_amdgcn_fence(__ATOMIC_RELEASE, "agent");
            asm volatile("s_waitcnt vmcnt(0)" ::: "memory");
            const unsigned og = xb_add(&bar[XB_TOP], 1u);
            const unsigned tg = og / nx;
            if (og + 1u == (tg + 1u) * nx) xb_add(&bar[XB_TOPGEN], 1u);
            else XB_SPIN(xb_ld(&bar[XB_TOPGEN]) == tg, bar);
            __builtin_amdgcn_fence(__ATOMIC_ACQUIRE, "agent");
            xb_add(&bar[XB_XGEN(b.x)], 1u);
            asm volatile("s_waitcnt vmcnt(0)" ::: "memory");
        } else {
            XB_SPIN(xb_ld(&bar[XB_XGEN(b.x)]) == gen, bar);
            __builtin_amdgcn_fence(__ATOMIC_ACQUIRE, "agent");
            asm volatile("s_waitcnt vmcnt(0)" ::: "memory");
        }
    }
    __syncthreads();
}

__global__ void __launch_bounds__(NTHREADS, 2) fwd(Args a) {
    extern __shared__ __attribute__((aligned(16))) unsigned char lds_raw[];
    LAS unsigned char* lds = (LAS unsigned char*)lds_raw;
    const int G = gridDim.x;
    if (threadIdx.x < 64) ((LAS unsigned*)(lds + 131072))[threadIdx.x] = 0u;
    __syncthreads();
    XcdBarrier bar = xcd_barrier_post((unsigned*)(a.ws + WS_CTL), (volatile LAS unsigned*)(lds + 131072));
    constexpr int VL = 10 + (REP_N - 1);
    for (int vp = a.ph_lo; vp < a.ph_hi; ++vp) {
        const int layer = vp / VL, vsub = vp % VL;
        const int sub = (REP_N == 1 || vsub <= REP_SUB) ? vsub : (vsub < REP_SUB + REP_N ? REP_SUB : vsub - (REP_N - 1));
        const int ph = vp == DEPTH * VL ? NPH - 1 : layer * 10 + sub;
        int tid = threadIdx.x; asm volatile("" : "+v"(tid));
        const int lane = tid & 63, wave = __builtin_amdgcn_readfirstlane(tid >> 6);
        const int gw = blockIdx.x * NWAVES + wave, ngw = G * NWAVES;
        unsigned char* ws = a.ws;
        float* ropec = (float*)(ws + WS_ROPE); float* ropes = ropec + SEQ * 32;
        float* ssq = (float*)(ws + WS_SSQ); float* lse = (float*)(ws + WS_LSE);
        bf16_t* wb0 = (bf16_t*)(ws + WS_W); bf16_t* wb1 = (bf16_t*)((unsigned char*)a.out + 80 * MiB);
        bf16_t* wb = layer == 1 ? wb1 : wb0;
        bf16_t* xb = (bf16_t*)(ws + WS_XB);
        unsigned char* R = ws + WS_R;
        bf16_t *Hb = (bf16_t*)(R + R_H), *QA = (bf16_t*)(R + R_QA), *KA = (bf16_t*)(R + R_KA), *VA = (bf16_t*)(R + R_VA), *QB = (bf16_t*)(R + R_QB), *KB = (bf16_t*)(R + R_KB), *VB = (bf16_t*)(R + R_VB),
               *GA = (bf16_t*)(R + R_GA), *GB = (bf16_t*)(R + R_GB), *YA = (bf16_t*)(R + R_YA), *YB = (bf16_t*)(R + R_YB);
        float* xout = a.out;

        if (ph == NPH - 1) {
            const float* gf = a.in[13];
            for (int row = gw; row < MTOK; row += 2 * ngw) {
                const int row2 = row + ngw < MTOK ? row + ngw : row;
                const float pa = lane < 16 ? ssq[(size_t)row * 16 + lane] : 0.f, pb = lane < 16 ? ssq[(size_t)row2 * 16 + lane] : 0.f;
                const u32x4* xra = (const u32x4*)(xb + (size_t)row * DM) + lane; const u32x4* xrb = (const u32x4*)(xb + (size_t)row2 * DM) + lane;
                const u32x4 ba0 = xra[0], ba1 = xra[64], bb0 = xrb[0], bb1 = xrb[64];
                const float rsa = rsqrtf(wave_sum(pa) * (1.0f / 1024.0f) + RMS_EPS), rsb = rsqrtf(wave_sum(pb) * (1.0f / 1024.0f) + RMS_EPS);
#pragma unroll
                for (int j = 0; j < 2; ++j) {
                    const f32x4 g0 = *((const f32x4*)gf + 2 * lane + 128 * j), g1 = *((const f32x4*)gf + 2 * lane + 128 * j + 1);
#pragma unroll
                    for (int rr = 0; rr < 2; ++rr) {
                        if (rr == 1 && row2 == row) continue;
                        const u32x4 b = rr == 0 ? (j == 0 ? ba0 : ba1) : (j == 0 ? bb0 : bb1); const float rs = rr == 0 ? rsa : rsb;
                        f32x4* orow = (f32x4*)(xout + (size_t)(rr == 0 ? row : row2) * DM);
                        f32x4 v0, v1; v0[0] = bf_lo(b[0]); v0[1] = bf_hi(b[0]); v0[2] = bf_lo(b[1]); v0[3] = bf_hi(b[1]); v1[0] = bf_lo(b[2]); v1[1] = bf_hi(b[2]); v1[2] = bf_lo(b[3]); v1[3] = bf_hi(b[3]);
                        __builtin_nontemporal_store(v0 * rs * g0, orow + 2 * lane + 128 * j); __builtin_nontemporal_store(v1 * rs * g1, orow + 2 * lane + 128 * j + 1);
                    }
                }
            }
        } else if (sub == 0) {
            const int L = layer;
            if (L == 0)
            for (int it = gw; it < 2 * 24576; it += 2 * ngw) {
                const int L0 = it >= 24576; const ConvDesc c0 = conv_desc(a, L0 ? wb1 : wb0, L0, it - L0 * 24576); f32x4 r0[4]; unsigned d0; conv_load(c0, lane, r0, d0);
                const int it1 = it + ngw;
                if (it1 < 2 * 24576) { const int L1 = it1 >= 24576; const ConvDesc c1 = conv_desc(a, L1 ? wb1 : wb0, L1, it1 - L1 * 24576); f32x4 r1[4]; unsigned d1; conv_load(c1, lane, r1, d1); conv_store(c0, r0, d0); conv_store(c1, r1, d1); }
                else conv_store(c0, r0, d0);
            }
            if (L == 0) {
                const float* x = a.in[0];
                for (int row = gw; row < MTOK; row += 2 * ngw) {
                    const int row2 = row + ngw < MTOK ? row + ngw : row;
                    const f32x4* xa = (const f32x4*)(x + (size_t)row * DM) + lane; const f32x4* xc = (const f32x4*)(x + (size_t)row2 * DM) + lane; f32x4 va[4], vb[4]; float sa = 0.f, sb = 0.f;
#pragma unroll
                    for (int j = 0; j < 4; ++j) { va[j] = __builtin_nontemporal_load(xa + 64 * j); vb[j] = __builtin_nontemporal_load(xc + 64 * j); }
#pragma unroll
                    for (int j = 0; j < 4; ++j) { sa += (va[j][0] * va[j][0] + va[j][1] * va[j][1]) + (va[j][2] * va[j][2] + va[j][3] * va[j][3]); sb += (vb[j][0] * vb[j][0] + vb[j][1] * vb[j][1]) + (vb[j][2] * vb[j][2] + vb[j][3] * vb[j][3]); }
                    sa = wave_sum(sa); sb = wave_sum(sb);
                    u32x2* oa = (u32x2*)(xb + (size_t)row * DM) + lane; u32x2* ob = (u32x2*)(xb + (size_t)row2 * DM) + lane;
#pragma unroll
                    for (int j = 0; j < 4; ++j) { u32x2 w; w[0] = pk2(va[j][0], va[j][1]); w[1] = pk2(va[j][2], va[j][3]); oa[64 * j] = w; }
                    if (lane < 16) ssq[(size_t)row * 16 + lane] = lane == 0 ? sa : 0.f;
                    if (row2 != row) {
#pragma unroll
                        for (int j = 0; j < 4; ++j) { u32x2 w; w[0] = pk2(vb[j][0], vb[j][1]); w[1] = pk2(vb[j][2], vb[j][3]); ob[64 * j] = w; }
                        if (lane < 16) ssq[(size_t)row2 * 16 + lane] = lane == 0 ? sb : 0.f;
                    }
                }
                for (int idx = blockIdx.x * NTHREADS + tid; idx < SEQ * 32; idx += G * NTHREADS) {
                    const int pos = idx >> 5, d = idx & 31;
                    const float invf = exp2f(-(float)d * 0.41524101186092033f);
                    const float ang = (float)pos * invf;
                    double rev = (double)ang * 0.15915494309189535; rev -= floor(rev);
                    ropec[idx] = __builtin_amdgcn_cosf((float)rev); ropes[idx] = __builtin_amdgcn_sinf((float)rev);
                }
            }
        } else if (sub == 4) {
            attnA_phase(QA, (bf16_t*)xout, KA, VA, lse, lds, gw, ngw, lane, wave);
        } else if (sub == 5) {
            attnB_phase(QB, KB, VB, YB, a.in[6] + (size_t)layer * 8 * 465, lds, gw, ngw, lane, wave);
            mix_phase((const bf16_t*)xout, lse, YB, blockIdx.x * NTHREADS + tid, G * NTHREADS);
        } else {
            const int npass = 1;
            for (int pass = 0; pass < npass; ++pass) {
                pg8::Gemm g; EpiAny E; E.R = R; E.xb = xb; E.ssq = ssq; E.ropec = ropec; E.alpha = 0.5f; E.mid_t = -1; int N;
                if (sub == 1 || sub == 8) { g.A = xb; g.Bt = (const bf16_t*)((unsigned char*)wb + (sub == 1 ? W_UP1 : W_UP2)); g.K = DM; N = NUP; E.kind = 0; }
                else if (sub == 2 || sub == 9) { g.A = Hb; g.Bt = (const bf16_t*)((unsigned char*)wb + (sub == 2 ? W_DOWN1 : W_DOWN2)); g.K = FF; N = DM; E.kind = 1; }
                else if (sub == 7) { g.A = GA; g.Bt = (const bf16_t*)((unsigned char*)wb + W_OUT); g.K = DM; N = DM; E.kind = 1; E.alpha = 1.0f; }
                else if (sub == 3) { g.A = xb; g.Bt = (const bf16_t*)((unsigned char*)wb + W_IN); g.K = DM; N = NIN; E.kind = 2; }
                else { g.A = YB; g.Bt = (const bf16_t*)((unsigned char*)wb + W_PA); g.K = 768; N = DM; E.kind = 3; E.mid_t = 4; }
                g.M = MTOK; g.N = N;
                pg8::StaticOrder S; S.init(MTOK, N, G, (int)blockIdx.x);
                pg8::gemm_phase<EpiAny, pg8::StaticOrder, true, true>(lds, g, S, E, tid);
                __syncthreads();
            }
        }
        if (vp + 1 < a.ph_hi && !(ph != NPH - 1 && layer == 1 && sub == 0)) {
            if (a.ph_lo < 0) cg::this_grid().sync();
            for (int s_ = 0; s_ < SYNC_N; ++s_) xcd_barrier(bar);
        }
    }
}

extern "C" void kernel_launch(void* const* d_in, const int* in_sizes, int n_in, void* d_out, int out_size, void* d_ws, size_t ws_size, hipStream_t stream) {
    static int grid = 0;
    if (grid == 0) {
        if (n_in != 14 || in_sizes[0] != MTOK * DM || out_size != MTOK * DM || ws_size < WS_NEED) {
            fprintf(stderr, "kernel_launch: unexpected shapes / workspace (n_in %d, in0 %d, out %d, ws %zu, need %zu)\n", n_in, n_in > 0 ? in_sizes[0] : -1, out_size, ws_size, (size_t)WS_NEED); grid = -1; return; }
        int dev = 0, cus = 0, per_cu = 0;
        hipGetDevice(&dev); hipDeviceGetAttribute(&cus, hipDeviceAttributeMultiprocessorCount, dev);
        if (hipFuncSetAttribute((const void*)fwd, hipFuncAttributeMaxDynamicSharedMemorySize, LDS_BYTES) != hipSuccess) { fprintf(stderr, "kernel_launch: hipFuncSetAttribute failed\n"); grid = -1; return; }
        if (hipOccupancyMaxActiveBlocksPerMultiprocessor(&per_cu, (const void*)fwd, NTHREADS, LDS_BYTES) != hipSuccess || per_cu < 1) { fprintf(stderr, "kernel_launch: occupancy query says %d\n", per_cu); per_cu = 1; }
        (void)hipGetLastError();
        grid = cus * 1;
        fprintf(stderr, "kernel_launch: cus %d per_cu %d grid %d ws %zu\n", cus, per_cu, grid, ws_size);
    }
    if (grid < 0) return;
    Args a{};
    for (int i = 0; i < 14; ++i) a.in[i] = (const float*)d_in[i];
    a.out = (float*)d_out; a.ws = (unsigned char*)d_ws;
    if (hipMemsetAsync((char*)d_ws + WS_CTL, 0, CTL_ZERO_BYTES, stream) != hipSuccess) { fprintf(stderr, "kernel_launch: memset failed\n"); return; }
#if MK_MULTI
    for (int ph = 0; ph < NPH; ++ph) { a.ph_lo = ph; a.ph_hi = ph + 1; hipLaunchKernelGGL(fwd, dim3(grid), dim3(NTHREADS), LDS_BYTES, stream, a); }
#else
    a.ph_lo = 0; a.ph_hi = DEPTH * (10 + (REP_N - 1)) + 1;
    void* kargs[] = {(void*)&a};
    hipError_t e = hipLaunchCooperativeKernel((const void*)fwd, dim3(grid), dim3(NTHREADS), kargs, LDS_BYTES, stream);
    if (e != hipSuccess) fprintf(stderr, "kernel_launch: cooperative launch failed: %s (grid %d)\n", hipGetErrorString(e), grid);
#endif
}
```

```cpp
#include <hip/hip_runtime.h>
#include <hip/hip_cooperative_groups.h>
#include <cstdio>
#include <cstdint>
#include <cmath>
namespace cg = cooperative_groups;

namespace pg8 {
#define PG8_LAS __attribute__((address_space(3)))
typedef unsigned short bf16_t;
typedef short bf16x8 __attribute__((ext_vector_type(8)));
typedef float f32x4 __attribute__((ext_vector_type(4)));
typedef unsigned u32x4 __attribute__((ext_vector_type(4)));
constexpr int BM = 256, BK = 64, HALF = 128, HTB = HALF * BK * 2, STAGE_BYTES = 8 * HTB, NXCD = 8, WGM = 4;

__host__ __device__ __forceinline__ int lds_byte(int r, int c) { const int st = (r >> 4) * 2 + (c >> 5), rr = r & 15, cc = c & 31, ob = rr * 64 + cc * 2; return st * 1024 + (ob ^ (((ob >> 9) & 1) << 5)); }
__host__ __device__ __forceinline__ void stage_rc(int b, int& R, int& C) { const int st = b / 1024, sb = b % 1024, swz = sb ^ (((sb >> 9) & 1) << 5); R = (st >> 1) * 16 + swz / 64; C = (st & 1) * 32 + (swz % 64) / 2; }
__host__ __device__ __forceinline__ int perm32(int rho) { const int n = rho >> 4, i = rho & 15; return 8 * (i >> 2) + 4 * n + (i & 3); }

struct Unit { int pm, pn; };
struct Gemm { const bf16_t* A; const bf16_t* Bt; int M, N, K; };

struct StaticOrder {
    int nM, nN, nwg, G, c;
    __host__ __device__ void init(int M, int N, int G_, int c_) { nM = M / BM; nN = N / BM; nwg = nM * nN; G = G_; c = c_; }
    __host__ __device__ bool next(int i, Unit& u) const {
        const long L = (long)i * G + c; if (L >= nwg) return false;
        int wgid = (int)L; { const int q = nwg / NXCD, r = nwg % NXCD, xcd = wgid % NXCD, off = wgid / NXCD; wgid = (xcd < r ? xcd * (q + 1) : r * (q + 1) + (xcd - r) * q) + off; }
        const int nig = WGM * nN, gid = wgid / nig, fm = gid * WGM, gsz = (nM - fm) < WGM ? (nM - fm) : WGM;
        u.pm = fm + ((wgid % nig) % gsz); u.pn = (wgid % nig) / gsz; return true;
    }
    __device__ __forceinline__ void a_ready(const Unit&) const {}
    __device__ __forceinline__ void done(const Unit&) const {}
};

template <class Epi, class Sched, bool ALIGN_EPI = false, bool SP2 = false>
__device__ __forceinline__ void gemm_phase(PG8_LAS unsigned char* lds, const Gemm g, const Sched& S, const Epi& E, const int tid_in) {
    const int tid = tid_in, wid = __builtin_amdgcn_readfirstlane(tid >> 6), lane = tid & 63, wr = wid >> 2, wc = wid & 3, fr = lane & 15, fq = lane >> 4;
    const int K = g.K, nt = K / BK;
    unsigned voffA[2], voffB[2];
#pragma unroll
    for (int i = 0; i < 2; ++i) { int R, C; stage_rc(tid * 16 + i * 8192, R, C); const int Rb = Epi::PERM ? ((R & ~31) + perm32(R & 31)) : R;
        voffA[i] = (unsigned)(R * K + C) * 2u; voffB[i] = (unsigned)(Rb * K + C) * 2u; }
    const size_t kstep = (size_t)(BK * 2);
    const size_t hstep = (size_t)HALF * K * 2;
    const size_t tstep = 2 * hstep;
    const unsigned ldsw = (unsigned)wid * 1024u;
    const int aoff = lds_byte(wr * 64 + fr, fq * 8), boff = lds_byte(wc * 32 + fr, fq * 8);
#define PG8_SA(b, h) (((b) * 2 + (h)) * HTB)
#define PG8_SB(b, h) ((4 + (b) * 2 + (h)) * HTB)
#define PG8_STAGE(bufoff, gbase, voff) do { _Pragma("unroll") for (int _i = 0; _i < 2; ++_i) \
        __builtin_amdgcn_global_load_lds((const unsigned*)((const char*)(gbase) + (voff)[_i]), (PG8_LAS unsigned*)(lds + (bufoff) + ldsw + _i * 8192), 16, 0, 0); } while (0)
#define PG8_LDA(dst, b, h) do { _Pragma("unroll") for (int m = 0; m < 4; ++m) _Pragma("unroll") for (int k = 0; k < 2; ++k) dst[m][k] = *(const PG8_LAS bf16x8*)(lds + PG8_SA(b, h) + aoff + m * 2048 + k * 1024); } while (0)
#define PG8_LDB(dst, b, h) do { _Pragma("unroll") for (int n = 0; n < 2; ++n) _Pragma("unroll") for (int k = 0; k < 2; ++k) dst[n][k] = *(const PG8_LAS bf16x8*)(lds + PG8_SB(b, h) + boff + n * 2048 + k * 1024); } while (0)
#define PG8_MMA(ai, bj, At, Bt) do { __builtin_amdgcn_s_setprio(1); _Pragma("unroll") for (int m = 0; m < 4; ++m) _Pragma("unroll") for (int n = 0; n < 2; ++n) _Pragma("unroll") for (int k = 0; k < 2; ++k) \
        acc[ai][bj][m][n] = __builtin_amdgcn_mfma_f32_16x16x32_bf16(Bt[n][k], At[m][k], acc[ai][bj][m][n], 0, 0, 0); __builtin_amdgcn_s_setprio(0); } while (0)
#define PG8_WAIT_V(n) asm volatile("s_waitcnt vmcnt(" #n ")" ::: "memory")
#define PG8_WAIT_L(n) asm volatile("s_waitcnt lgkmcnt(" #n ")" ::: "memory")
#define PG8_BAR __builtin_amdgcn_s_barrier()
#define PG8_SCHED __builtin_amdgcn_sched_barrier(0)
    Unit cur, nxt; int ui = 0;
    if (!S.next(0, cur)) return;
    f32x4 acc[2][2][4][2];
#pragma unroll
    for (int a = 0; a < 2; ++a)
#pragma unroll
        for (int b = 0; b < 2; ++b)
#pragma unroll
            for (int m = 0; m < 4; ++m)
#pragma unroll
                for (int n = 0; n < 2; ++n) acc[a][b][m][n] = (f32x4){0.f, 0.f, 0.f, 0.f};
    bf16x8 At[4][2], B0[2][2], B1[2][2];
    const char* cA = (const char*)g.A + (size_t)cur.pm * tstep; const char* cB = (const char*)g.Bt + (size_t)cur.pn * tstep;
    S.a_ready(cur);
    if constexpr (SP2) {
        PG8_STAGE(PG8_SB(0, 0), cB, voffB); PG8_STAGE(PG8_SB(0, 1), cB + hstep, voffB); PG8_STAGE(PG8_SA(0, 0), cA, voffA); PG8_STAGE(PG8_SA(0, 1), cA + hstep, voffA);
        if (wr == 1) PG8_BAR;
        PG8_WAIT_V(2); PG8_BAR;
        PG8_STAGE(PG8_SB(1, 0), cB + kstep, voffB); PG8_STAGE(PG8_SA(1, 0), cA + kstep, voffA); PG8_STAGE(PG8_SB(1, 1), cB + hstep + kstep, voffB);
        PG8_WAIT_V(6); PG8_BAR;
    } else {
        PG8_STAGE(PG8_SB(0, 0), cB, voffB); PG8_STAGE(PG8_SA(0, 0), cA, voffA); PG8_STAGE(PG8_SB(0, 1), cB + hstep, voffB); PG8_STAGE(PG8_SA(0, 1), cA + hstep, voffA);
        if (wr == 1) PG8_BAR;
        PG8_WAIT_V(4); PG8_BAR;
        PG8_STAGE(PG8_SB(1, 0), cB + kstep, voffB); PG8_STAGE(PG8_SA(1, 0), cA + kstep, voffA); PG8_STAGE(PG8_SB(1, 1), cB + hstep + kstep, voffB);
        PG8_WAIT_V(6); PG8_BAR;
    }
    for (;;) {
        const bool has_next = S.next(ui + 1, nxt);
        const char* nA = has_next ? (const char*)g.A + (size_t)nxt.pm * tstep : cA; const char* nB = has_next ? (const char*)g.Bt + (size_t)nxt.pn * tstep : cB;
        for (int t = 0; t < nt; t += 2) {
            if (t == E.mid_t) E.mid(acc, cur, wr, wc, fr, fq);
            const bool last = (t == nt - 2);
            const char* a1 = cA + (size_t)(t + 1) * kstep;
            const char* a2 = last ? nA : cA + (size_t)(t + 2) * kstep; const char* b2 = last ? nB : cB + (size_t)(t + 2) * kstep;
            const char* a3 = a2 + kstep; const char* b3 = b2 + kstep;
            if (last && has_next) S.a_ready(nxt);
            if constexpr (SP2) {
            PG8_LDB(B0, 0, 0); PG8_LDB(B1, 0, 1); PG8_SCHED; PG8_LDA(At, 0, 0); PG8_STAGE(PG8_SA(1, 1), a1 + hstep, voffA);
            PG8_WAIT_V(8); PG8_WAIT_L(0); PG8_BAR; PG8_MMA(0, 0, At, B0); PG8_MMA(0, 1, At, B1); PG8_BAR; PG8_SCHED;
            PG8_LDA(At, 0, 1); PG8_STAGE(PG8_SB(0, 0), b2, voffB); PG8_STAGE(PG8_SB(0, 1), b2 + hstep, voffB); PG8_STAGE(PG8_SA(0, 0), a2, voffA);
            PG8_WAIT_V(8); PG8_WAIT_L(0); PG8_BAR; PG8_MMA(1, 0, At, B0); PG8_MMA(1, 1, At, B1); PG8_BAR; PG8_SCHED;
            PG8_LDB(B0, 1, 0); PG8_LDB(B1, 1, 1); PG8_SCHED; PG8_LDA(At, 1, 0); PG8_STAGE(PG8_SA(0, 1), a2 + hstep, voffA);
            PG8_WAIT_V(8); PG8_WAIT_L(0); PG8_BAR; PG8_MMA(0, 0, At, B0); PG8_MMA(0, 1, At, B1); PG8_BAR; PG8_SCHED;
            PG8_LDA(At, 1, 1); PG8_STAGE(PG8_SB(1, 0), b3, voffB); PG8_STAGE(PG8_SB(1, 1), b3 + hstep, voffB); PG8_STAGE(PG8_SA(1, 0), a3, voffA);
            PG8_WAIT_V(8); PG8_WAIT_L(0); PG8_BAR; PG8_MMA(1, 0, At, B0); PG8_MMA(1, 1, At, B1); PG8_BAR; PG8_SCHED;
            } else {
            PG8_LDB(B0, 0, 0); PG8_SCHED; PG8_LDA(At, 0, 0); PG8_STAGE(PG8_SA(1, 1), a1 + hstep, voffA);
            PG8_WAIT_L(8); PG8_BAR; PG8_WAIT_L(0); PG8_MMA(0, 0, At, B0); PG8_BAR; PG8_SCHED;
            PG8_LDB(B1, 0, 1); PG8_STAGE(PG8_SB(0, 0), b2, voffB);
            PG8_BAR; PG8_WAIT_L(0); PG8_MMA(0, 1, At, B1); PG8_BAR;
            PG8_LDA(At, 0, 1); PG8_STAGE(PG8_SA(0, 0), a2, voffA);
            PG8_BAR; PG8_WAIT_L(0); PG8_MMA(1, 0, At, B0); PG8_BAR; PG8_SCHED;
            PG8_STAGE(PG8_SB(0, 1), b2 + hstep, voffB);
            PG8_WAIT_V(6); PG8_BAR; PG8_MMA(1, 1, At, B1); PG8_BAR;
            PG8_LDB(B0, 1, 0); PG8_SCHED; PG8_LDA(At, 1, 0); PG8_STAGE(PG8_SA(0, 1), a2 + hstep, voffA);
            PG8_WAIT_L(8); PG8_BAR; PG8_WAIT_L(0); PG8_MMA(0, 0, At, B0); PG8_BAR; PG8_SCHED;
            PG8_LDB(B1, 1, 1); PG8_STAGE(PG8_SB(1, 0), b3, voffB);
            PG8_BAR; PG8_WAIT_L(0); PG8_MMA(0, 1, At, B1); PG8_BAR;
            PG8_LDA(At, 1, 1); PG8_STAGE(PG8_SA(1, 0), a3, voffA);
            PG8_BAR; PG8_WAIT_L(0); PG8_MMA(1, 0, At, B0); PG8_BAR; PG8_SCHED;
            PG8_STAGE(PG8_SB(1, 1), b3 + hstep, voffB);
            PG8_WAIT_V(6); PG8_BAR; PG8_MMA(1, 1, At, B1); PG8_BAR;
            }
        }
        if constexpr (ALIGN_EPI) { if (wr == 0) PG8_BAR; }
        if constexpr (!Epi::AFTER_DRAIN) { E(acc, cur, wr, wc, fr, fq); S.done(cur); }
        if (!has_next) break;
#pragma unroll
        for (int a = 0; a < 2; ++a)
#pragma unroll
            for (int b = 0; b < 2; ++b)
#pragma unroll
                for (int m = 0; m < 4; ++m)
#pragma unroll
                    for (int n = 0; n < 2; ++n) acc[a][b][m][n] = (f32x4){0.f, 0.f, 0.f, 0.f};
        cur = nxt; cA = nA; cB = nB; ++ui;
        if constexpr (ALIGN_EPI) { if (wr == 1) PG8_BAR; }
    }
    PG8_WAIT_V(0);
    if constexpr (!ALIGN_EPI) { if (wr == 0) PG8_BAR; }
    PG8_BAR;
    if constexpr (Epi::AFTER_DRAIN) { E.fused(acc, cur, wr, wc, fr, fq, lds, wid, lane); S.done(cur); }
#undef PG8_SA
#undef PG8_SB
#undef PG8_STAGE
#undef PG8_LDA
#undef PG8_LDB
#undef PG8_MMA
#undef PG8_WAIT_V
#undef PG8_WAIT_L
#undef PG8_BAR
#undef PG8_SCHED
}
}

using pg8::bf16_t; using pg8::f32x4; using pg8::u32x4; using pg8::bf16x8;
#define LAS __attribute__((address_space(3)))
typedef float f32x16 __attribute__((ext_vector_type(16)));
typedef short s16x4 __attribute__((ext_vector_type(4)));
typedef short v4i16_t __attribute__((ext_vector_type(4)));
typedef unsigned u32x2 __attribute__((ext_vector_type(2)));
typedef float f32x2_t __attribute__((ext_vector_type(2)));
typedef __bf16 bf16x2_t __attribute__((ext_vector_type(2)));

#ifndef REP_SUB
#define REP_SUB 0
#endif
#ifndef REP_N
#define REP_N 1
#endif
#ifndef SYNC_N
#define SYNC_N 1
#endif
#ifndef H_STORE_BITS
#define H_STORE_BITS "sc0 sc1"
#endif
#ifndef MK_MULTI
#define MK_MULTI 0
#endif

constexpr int BATCH = 16, SEQ = 2048, DM = 1024, MTOK = BATCH * SEQ, FF = 2816, NUP = 2 * FF, NIN = 5888, DEPTH = 2;
constexpr float RMS_EPS = 1e-6f, LOG2E = 1.4426950408889634f, QSCALE = 0.125f * 1.4426950408889634f;
constexpr int NPH = DEPTH * 10 + 1;
constexpr int NTHREADS = 512, NWAVES = 8;
constexpr int LDS_BYTES = 131072 + 1024;

constexpr size_t MiB = 1u << 20;
constexpr size_t WS_CTL = 0, CTL_ZERO_BYTES = 65536;
constexpr size_t WS_ROPE = 1 * MiB;
constexpr size_t WS_SSQ = 2 * MiB;
constexpr size_t WS_LSE = 4 * MiB;
constexpr size_t WS_W = 8 * MiB;
constexpr size_t W_UP1 = 0, W_DOWN1 = 11 * MiB, W_IN = W_DOWN1 + 11 * MiB / 2, W_PA = 28 * MiB, W_PB = W_PA + MiB / 2, W_OUT = W_PB + MiB, W_UP2 = W_OUT + 2 * MiB, W_DOWN2 = W_UP2 + 11 * MiB;
static_assert(W_IN + (size_t)NIN * DM * 2 == W_PA && W_DOWN2 + (size_t)DM * FF * 2 == 48 * MiB, "weight map");
constexpr size_t WS_XB = 56 * MiB;
constexpr size_t WS_R = 120 * MiB;
constexpr size_t R_H = 0;
constexpr size_t R_QA = 0, R_KA = 48 * MiB, R_VA = 96 * MiB, R_QB = 144 * MiB, R_KB = 176 * MiB, R_VB = 208 * MiB, R_GA = 240 * MiB, R_GB = 304 * MiB, R_YA = 368 * MiB, R_YB = R_KA, R_END = 384 * MiB;
constexpr size_t WS_NEED = WS_R + R_END;

struct Args { const float* in[14]; float* out; unsigned char* ws; int ph_lo, ph_hi; };

__device__ __forceinline__ unsigned pk2(float lo, float hi) { f32x2_t v = {lo, hi}; bf16x2_t b = __builtin_convertvector(v, bf16x2_t); return __builtin_bit_cast(unsigned, b); }
__device__ __forceinline__ float bf_lo(unsigned u) { return __uint_as_float(u << 16); }
__device__ __forceinline__ float bf_hi(unsigned u) { return __uint_as_float(u & 0xffff0000u); }
__device__ __forceinline__ float fast_sigmoid(float z) { return __builtin_amdgcn_rcpf(1.0f + __expf(-z)); }

__device__ __forceinline__ float row_rs(const float* ssq, unsigned row, int fq) {
    const f32x4 p = *(const f32x4*)(ssq + (row * 16u + fq * 4));
    float s = (p[0] + p[1]) + (p[2] + p[3]);
    s += __shfl_xor(s, 16); s += __shfl_xor(s, 32);
    return rsqrtf(s * (1.0f / 1024.0f) + RMS_EPS);
}

__device__ __forceinline__ void load_rs8(const float* ssq, unsigned row0, int fq, float (&rs)[8]) {
    f32x4 p[8];
#pragma unroll
    for (int k = 0; k < 8; ++k) p[k] = *(const f32x4*)(ssq + ((row0 + (k >> 2) * 128 + (k & 3) * 16) * 16u + fq * 4));
#pragma unroll
    for (int k = 0; k < 8; ++k) { float s = (p[k][0] + p[k][1]) + (p[k][2] + p[k][3]); s += __shfl_xor(s, 16); s += __shfl_xor(s, 32); rs[k] = rsqrtf(s * (1.0f / 1024.0f) + RMS_EPS); }
}
struct EpiAny {
    static constexpr bool PERM = true, AFTER_DRAIN = false;
    int kind; int mid_t; float alpha; unsigned char* R; bf16_t* xb; float* ssq; const float* ropec;
    __device__ __forceinline__ void mid(f32x4 (&acc)[2][2][4][2], const pg8::Unit& u, int wr, int wc, int fr, int fq) const {
        const bf16_t* GA = (const bf16_t*)(R + R_GA); const bf16_t* GB = (const bf16_t*)(R + R_GB);
        unsigned row0 = u.pm * 256 + wr * 64 + fr; asm volatile("" : "+v"(row0));
        const unsigned col0 = u.pn * 256 + wc * 32 + 8 * fq;
#pragma unroll
        for (int ai = 0; ai < 2; ++ai) {
            u32x4 tv[4][2], gv[4][2];
#pragma unroll
            for (int m = 0; m < 4; ++m)
#pragma unroll
                for (int bj = 0; bj < 2; ++bj) { const unsigned off = (row0 + ai * 128 + m * 16) * (unsigned)DM + col0 + bj * 128; tv[m][bj] = *(const u32x4*)(GA + off); gv[m][bj] = *(const u32x4*)(GB + off); }
#pragma unroll
            for (int m = 0; m < 4; ++m)
#pragma unroll
                for (int bj = 0; bj < 2; ++bj)
#pragma unroll
                    for (int n = 0; n < 2; ++n)
#pragma unroll
                        for (int i = 0; i < 2; ++i) {
                            const unsigned ta = tv[m][bj][2 * n + i], tb = gv[m][bj][2 * n + i];
                            acc[ai][bj][m][n][2 * i] *= bf_lo(ta) * __builtin_amdgcn_rcpf(fmaxf(bf_lo(tb), 1e-30f));
                            acc[ai][bj][m][n][2 * i + 1] *= bf_hi(ta) * __builtin_amdgcn_rcpf(fmaxf(bf_hi(tb), 1e-30f));
                        }
            asm volatile("" ::: "memory");
        }
    }
    __device__ __forceinline__ void operator()(const f32x4 (&acc)[2][2][4][2], const pg8::Unit& u, int wr, int wc, int fr, int fq) const {
        const unsigned row0 = u.pm * 256 + wr * 64 + fr;
        if (kind == 0) {
            bf16_t* H = (bf16_t*)(R + R_H); const unsigned col0 = u.pn * 128 + wc * 32 + 8 * fq;
            float rs8[8]; load_rs8(ssq, row0, fq, rs8);
#pragma unroll
            for (int ai = 0; ai < 2; ++ai)
#pragma unroll
                for (int m = 0; m < 4; ++m) {
                    const unsigned row = row0 + ai * 128 + m * 16; const float rs = rs8[ai * 4 + m];
                    u32x4 w;
#pragma unroll
                    for (int n = 0; n < 2; ++n) {
                        const f32x4 g = acc[ai][0][m][n] * rs, up = acc[ai][1][m][n] * rs; f32x4 hh;
#pragma unroll
                        for (int i = 0; i < 4; ++i) hh[i] = g[i] * fast_sigmoid(g[i]) * up[i];
                        w[2 * n] = pk2(hh[0], hh[1]); w[2 * n + 1] = pk2(hh[2], hh[3]);
                    }
                    { bf16_t* hp_ = H + (row * (unsigned)FF + col0); asm volatile("global_store_dwordx4 %0, %1, off " H_STORE_BITS "\n\ts_nop 1" :: "v"(hp_), "v"(w) : "memory"); }
                }
        } else if (kind == 1) {
            const unsigned col0 = u.pn * 256 + wc * 32 + 8 * fq;
#pragma unroll
            for (int hb = 0; hb < 2; ++hb) { const int ai = hb;
                u32x4 bv[4][2];
#pragma unroll
                for (int m = 0; m < 4; ++m)
#pragma unroll
                    for (int bj = 0; bj < 2; ++bj) { const unsigned off = (row0 + ai * 128 + m * 16) * (unsigned)DM + col0 + bj * 128; bv[m][bj] = *(const u32x4*)(xb + off); }
#pragma unroll
                for (int m = 0; m < 4; ++m) {
                    const unsigned row = row0 + ai * 128 + m * 16; float sq = 0.f;
#pragma unroll
                    for (int bj = 0; bj < 2; ++bj) {
                        const unsigned off = row * (unsigned)DM + col0 + bj * 128; const u32x4 b = bv[m][bj];
                        f32x4 v0, v1;
                        v0[0] = bf_lo(b[0]); v0[1] = bf_hi(b[0]); v0[2] = bf_lo(b[1]); v0[3] = bf_hi(b[1]); v1[0] = bf_lo(b[2]); v1[1] = bf_hi(b[2]); v1[2] = bf_lo(b[3]); v1[3] = bf_hi(b[3]);
                        v0 = v0 + acc[ai][bj][m][0] * alpha; v1 = v1 + acc[ai][bj][m][1] * alpha;
                        u32x4 w; w[0] = pk2(v0[0], v0[1]); w[1] = pk2(v0[2], v0[3]); w[2] = pk2(v1[0], v1[1]); w[3] = pk2(v1[2], v1[3]);
                        *(u32x4*)(xb + off) = w;
                        sq += (v0[0] * v0[0] + v0[1] * v0[1]) + (v0[2] * v0[2] + v0[3] * v0[3]) + (v1[0] * v1[0] + v1[1] * v1[1]) + (v1[2] * v1[2] + v1[3] * v1[3]);
                    }
                    sq += __shfl_xor(sq, 16); sq += __shfl_xor(sq, 32);
                    if (fq == 0) ssq[row * 16u + u.pn * 4 + wc] = sq;
                }
                asm volatile("" ::: "memory");
            }
        } else if (kind == 2) {
            const int pn = u.pn; size_t boff; unsigned ld, pl; int mode; float sc = 1.f;
            if (pn < 3) { boff = R_QA; ld = 768; pl = pn; mode = 1; sc = QSCALE; }
            else if (pn < 6) { boff = R_KA; ld = 768; pl = pn - 3; mode = 1; }
            else if (pn < 9) { boff = R_VA; ld = 768; pl = pn - 6; mode = 0; }
            else if (pn < 11) { boff = R_QB; ld = 512; pl = pn - 9; mode = 0; sc = QSCALE; }
            else if (pn < 13) { boff = R_KB; ld = 512; pl = pn - 11; mode = 0; }
            else if (pn < 15) { boff = R_VB; ld = 512; pl = pn - 13; mode = 0; }
            else if (pn < 19) { boff = R_GA; ld = 1024; pl = pn - 15; mode = 2; }
            else { boff = R_GB; ld = 1024; pl = pn - 19; mode = 2; }
            bf16_t* ob = (bf16_t*)(R + boff);
            float rs8[8]; load_rs8(ssq, row0, fq, rs8);
            if (mode == 1) {
                const unsigned colo = (4 * pl + wc) * 64 + 8 * fq; const float* ropes = ropec + SEQ * 32;
#pragma unroll
                for (int hb = 0; hb < 4; ++hb) { const int ai = hb >> 1, mb = 2 * (hb & 1);
                    f32x4 cv[4][2], sv[4][2];
#pragma unroll
                    for (int m = mb; m < mb + 2; ++m)
#pragma unroll
                        for (int n = 0; n < 2; ++n) { const unsigned ro = ((row0 + ai * 128 + m * 16) & (SEQ - 1)) * 32 + 8 * fq + 4 * n; cv[m][n] = *(const f32x4*)(ropec + ro); sv[m][n] = *(const f32x4*)(ropes + ro); }
#pragma unroll
                    for (int m = mb; m < mb + 2; ++m) {
                        const unsigned row = row0 + ai * 128 + m * 16; const float rs = rs8[ai * 4 + m];
                        u32x4 w1, w2;
#pragma unroll
                        for (int n = 0; n < 2; ++n) {
                            const f32x4 c = cv[m][n], s = sv[m][n];
                            const f32x4 t1 = acc[ai][0][m][n] * rs, t2 = acc[ai][1][m][n] * rs;
                            const f32x4 o1 = (t1 * c - t2 * s) * sc, o2 = (t2 * c + t1 * s) * sc;
                            w1[2 * n] = pk2(o1[0], o1[1]); w1[2 * n + 1] = pk2(o1[2], o1[3]); w2[2 * n] = pk2(o2[0], o2[1]); w2[2 * n + 1] = pk2(o2[2], o2[3]);
                        }
                        const unsigned off = row * 768u + colo;
                        *(u32x4*)(ob + off) = w1; *(u32x4*)(ob + off + 32) = w2;
                    }
                    asm volatile("" ::: "memory");
                }
            } else {
                const unsigned colo = pl * 256 + wc * 32 + 8 * fq;
#pragma unroll
                for (int ai = 0; ai < 2; ++ai)
#pragma unroll
                    for (int m = 0; m < 4; ++m) {
                        const unsigned row = row0 + ai * 128 + m * 16; const float f = rs8[ai * 4 + m] * sc;
#pragma unroll
                        for (int bj = 0; bj < 2; ++bj) {
                            f32x4 v0 = acc[ai][bj][m][0] * f, v1 = acc[ai][bj][m][1] * f;
                            if (mode == 2) {
#pragma unroll
                                for (int i = 0; i < 4; ++i) { v0[i] = fast_sigmoid(v0[i]); v1[i] = fast_sigmoid(v1[i]); }
                            }
                            u32x4 w; w[0] = pk2(v0[0], v0[1]); w[1] = pk2(v0[2], v0[3]); w[2] = pk2(v1[0], v1[1]); w[3] = pk2(v1[2], v1[3]);
                            *(u32x4*)(ob + (row * ld + colo + bj * 128)) = w;
                        }
                    }
            }
        } else {
            bf16_t* GA = (bf16_t*)(R + R_GA); const bf16_t* GB = (const bf16_t*)(R + R_GB);
            const unsigned col0 = u.pn * 256 + wc * 32 + 8 * fq;
#pragma unroll
            for (int hb = 0; hb < 2; ++hb) { const int ai = hb, mb = 0;
                u32x4 gv[4][2];
#pragma unroll
                for (int m = mb; m < mb + 4; ++m)
#pragma unroll
                    for (int bj = 0; bj < 2; ++bj) { const unsigned off = (row0 + ai * 128 + m * 16) * (unsigned)DM + col0 + bj * 128; gv[m][bj] = *(const u32x4*)(GB + off); }
#pragma unroll
                for (int m = mb; m < mb + 4; ++m)
#pragma unroll
                    for (int bj = 0; bj < 2; ++bj) {
                        const unsigned off = (row0 + ai * 128 + m * 16) * (unsigned)DM + col0 + bj * 128;
                        const u32x4 g = gv[m][bj]; const f32x4 a0 = acc[ai][bj][m][0], a1 = acc[ai][bj][m][1]; u32x4 w;
                        w[0] = pk2(bf_lo(g[0]) * a0[0], bf_hi(g[0]) * a0[1]); w[1] = pk2(bf_lo(g[1]) * a0[2], bf_hi(g[1]) * a0[3]);
                        w[2] = pk2(bf_lo(g[2]) * a1[0], bf_hi(g[2]) * a1[1]); w[3] = pk2(bf_lo(g[3]) * a1[2], bf_hi(g[3]) * a1[3]);
                        *(u32x4*)(GA + off) = w;
                    }
                asm volatile("" ::: "memory");
            }
        }
    }
};

__device__ __forceinline__ int crow(int r, int hi) { return (r & 3) + 8 * (r >> 2) + 4 * hi; }
__device__ __forceinline__ s16x4 vtr(LAS unsigned char* p) { return __builtin_bit_cast(s16x4, __builtin_amdgcn_ds_read_tr16_b64_v4i16((LAS v4i16_t*)p)); }
#define CBAR() asm volatile("" ::: "memory")

__device__ __forceinline__ void v_tile_store(LAS unsigned char* vl, const u32x4 (&vc)[4], int lane) {
    const int dc = lane & 7;
#pragma unroll
    for (int i = 0; i < 4; ++i) { const int key = (lane >> 3) + 8 * i; *(LAS u32x4*)(vl + (dc >> 2) * 2048 + key * 64 + (dc & 3) * 16) = vc[i]; }
}
__device__ __forceinline__ void k_tile_store(LAS unsigned char* kl, const u32x4 (&kc)[4], int lane) {
#pragma unroll
    for (int i = 0; i < 4; ++i) *(LAS u32x4*)(kl + ((lane >> 3) + 8 * i) * 144 + (lane & 7) * 16) = kc[i];
}
__device__ __forceinline__ void k_frag_load(LAS unsigned char* kl, bf16x8 (&kf)[4], int lane) {
#pragma unroll
    for (int s = 0; s < 4; ++s) kf[s] = *(const LAS bf16x8*)(kl + (lane & 31) * 144 + s * 32 + (lane >> 5) * 16);
}
__device__ __forceinline__ void softmax_pv(f32x16& s, float& m, float& l, f32x16& o0, f32x16& o1, LAS unsigned char* vl, int lane) {
    const int hi = lane >> 5;
    float mx = s[0];
#pragma unroll
    for (int r = 1; r < 16; ++r) mx = fmaxf(mx, s[r]);
    mx = fmaxf(mx, __shfl_xor(mx, 32));
    if (__any(mx > m + 8.0f)) {
        const float mn = fmaxf(m, mx), alpha = __builtin_amdgcn_exp2f(m - mn);
        m = mn; l *= alpha;
#pragma unroll
        for (int r = 0; r < 16; ++r) { o0[r] *= alpha; o1[r] *= alpha; }
    }
    float sum = 0.f;
#pragma unroll
    for (int r = 0; r < 16; ++r) { s[r] = __builtin_amdgcn_exp2f(s[r] - m); sum += s[r]; }
    l += sum;
    u32x4 p0, p1;
#pragma unroll
    for (int i = 0; i < 4; ++i) { p0[i] = pk2(s[2 * i], s[2 * i + 1]); p1[i] = pk2(s[8 + 2 * i], s[8 + 2 * i + 1]); }
    const bf16x8 pb0 = __builtin_bit_cast(bf16x8, p0), pb1 = __builtin_bit_cast(bf16x8, p1);
    LAS unsigned char* vb = vl + (4 * hi + ((lane & 15) >> 2)) * 64 + (16 * ((lane >> 4) & 1) + 4 * (lane & 3)) * 2;
#pragma unroll
    for (int dt = 0; dt < 2; ++dt) {
#pragma unroll
        for (int ks = 0; ks < 2; ++ks) {
            const s16x4 lo = vtr(vb + dt * 2048 + ks * 1024), hh = vtr(vb + dt * 2048 + ks * 1024 + 512);
            const bf16x8 vf = (bf16x8){lo[0], lo[1], lo[2], lo[3], hh[0], hh[1], hh[2], hh[3]};
            if (dt == 0) o0 = __builtin_amdgcn_mfma_f32_32x32x16_bf16(vf, ks == 0 ? pb0 : pb1, o0, 0, 0, 0);
            else         o1 = __builtin_amdgcn_mfma_f32_32x32x16_bf16(vf, ks == 0 ? pb0 : pb1, o1, 0, 0, 0);
        }
    }
}
__device__ __forceinline__ void attn_store(bf16_t* orow, const f32x16& o0, const f32x16& o1, float inv, int hi) {
#pragma unroll
    for (int g = 0; g < 4; ++g) {
        u32x2 w0, w1;
        w0[0] = pk2(o0[4 * g] * inv, o0[4 * g + 1] * inv); w0[1] = pk2(o0[4 * g + 2] * inv, o0[4 * g + 3] * inv);
        w1[0] = pk2(o1[4 * g] * inv, o1[4 * g + 1] * inv); w1[1] = pk2(o1[4 * g + 2] * inv, o1[4 * g + 3] * inv);
        *(u32x2*)(orow + 8 * g + 4 * hi) = w0; *(u32x2*)(orow + 32 + 8 * g + 4 * hi) = w1;
    }
}

__device__ __forceinline__ void attnA_phase(const bf16_t* QA, bf16_t* OA, const bf16_t* KA, const bf16_t* VA, float* LSE, LAS unsigned char* lds, int gw, int ngw, int lane, int wave) {
    LAS unsigned char* vl = lds + wave * 16384;
    const int q = lane & 31, hi = lane >> 5;
    for (int it = gw; it < BATCH * 12 * 64; it += ngw) {
        const int b = it / 768, rem = it % 768, h = rem >> 6, qt = rem & 63;
        const int dsh = 2 * (h >> 2), tpr = 64 >> dsh, rho = qt >> (6 - dsh), lt = qt & (tpr - 1);
        const size_t rowb = (size_t)b * SEQ;
        const int tq = ((lt * 32 + q) << dsh) + rho;
        const bf16_t* Qp = QA + (rowb + tq) * 768 + h * 64;
        bf16x8 qf[4];
#pragma unroll
        for (int s = 0; s < 4; ++s) qf[s] = *(const bf16x8*)(Qp + 16 * s + 8 * hi);
        const int k_lo = lt - 2 < 0 ? 0 : lt - 2, k_hi = lt + 2 > tpr - 1 ? tpr - 1 : lt + 2;
        float m = -1e30f, l = 0.f; f32x16 o0 = {}, o1 = {};
        bf16x8 kf[4]; u32x4 vc[4], kc[4]; LAS unsigned char* kl = vl + 8192;
#pragma unroll
        for (int i = 0; i < 4; ++i) { const int tv = ((k_lo * 32 + (lane >> 3) + 8 * i) << dsh) + rho; const size_t o_ = (rowb + tv) * 768 + h * 64 + (lane & 7) * 8; kc[i] = *(const u32x4*)(KA + o_); vc[i] = *(const u32x4*)(VA + o_); }
        for (int kt = k_lo; kt <= k_hi; ++kt) {
            CBAR(); v_tile_store(vl, vc, lane); k_tile_store(kl, kc, lane); CBAR();
            k_frag_load(kl, kf, lane); CBAR();
            if (kt < k_hi) {
#pragma unroll
                for (int i = 0; i < 4; ++i) { const int tv = (((kt + 1) * 32 + (lane >> 3) + 8 * i) << dsh) + rho; const size_t o_ = (rowb + tv) * 768 + h * 64 + (lane & 7) * 8; kc[i] = *(const u32x4*)(KA + o_); vc[i] = *(const u32x4*)(VA + o_); }
            }
            f32x16 s = {};
#pragma unroll
            for (int ss = 0; ss < 4; ++ss) s = __builtin_amdgcn_mfma_f32_32x32x16_bf16(kf[ss], qf[ss], s, 0, 0, 0);
            const int dk = kt - lt;
            if (dk == -2) {
#pragma unroll
                for (int r = 0; r < 16; ++r) if (crow(r, hi) < q) s[r] = -INFINITY;
            } else if (dk == 2) {
#pragma unroll
                for (int r = 0; r < 16; ++r) if (crow(r, hi) > q) s[r] = -INFINITY;
            }
            softmax_pv(s, m, l, o0, o1, vl, lane);
        }
        const float lt_ = l + __shfl_xor(l, 32), inv = 1.0f / lt_;
        attn_store(OA + (rowb + tq) * 768 + h * 64, o0, o1, inv, hi);
        if (hi == 0) LSE[(rowb + tq) * 12 + h] = m + __builtin_amdgcn_logf(lt_);
    }
}

__device__ __forceinline__ void attnB_phase(const bf16_t* QB, const bf16_t* KB, const bf16_t* VB, bf16_t* YB, const float* relb, LAS unsigned char* lds, int gw, int ngw, int lane, int wave) {
    LAS unsigned char* vl = lds + wave * 16384; LAS float* bl = (LAS float*)(vl + 4096);
    const int q = lane & 31, hi = lane >> 5; int h_loaded = -1;
    for (int it = gw; it < BATCH * 8 * 64; it += ngw) {
        const int b = it >> 9, rem = it & 511, h = rem >> 6, rp = (rem >> 2) & 15, cb = rem & 3;
        const int q_row = 2 * rp + (q >> 4), q_col = 16 * cb + (q & 15), tq = q_row * 64 + q_col;
        int kc0 = 16 * cb - 8; kc0 = kc0 < 0 ? 0 : (kc0 > 32 ? 32 : kc0);
        int lo0 = 2 * rp - 4; lo0 = lo0 < 0 ? 0 : (lo0 > 24 ? 24 : lo0);
        int lo1 = 2 * rp - 3; lo1 = lo1 < 0 ? 0 : (lo1 > 24 ? 24 : lo1);
        const int ntile = lo1 + 8 - lo0;
        int my_lo = q_row - 4; my_lo = my_lo < 0 ? 0 : (my_lo > 24 ? 24 : my_lo);
        int win_lo = q_col - 8; win_lo = win_lo < 0 ? 0 : (win_lo > 48 ? 48 : win_lo);
        const size_t rowb = (size_t)b * SEQ;
        if (h != h_loaded) {
            CBAR();
            for (int i = lane; i < 16 * 64; i += 64) { const int rr = i >> 6, c = i & 63; float v = rr == 15 ? -INFINITY : 0.f; if (rr < 15 && c >= 16 && c < 47) v = relb[h * 465 + rr * 31 + (c - 16)] * LOG2E; bl[i] = v; }
            CBAR(); h_loaded = h;
        }
        const bf16_t* Qp = QB + (rowb + tq) * 512 + h * 64;
        bf16x8 qf[4];
#pragma unroll
        for (int s = 0; s < 4; ++s) qf[s] = *(const bf16x8*)(Qp + 16 * s + 8 * hi);
        float m = -1e30f, l = 0.f; f32x16 o0 = {}, o1 = {};
        bf16x8 kf[4]; u32x4 vc[4], kc[4]; LAS unsigned char* kl = vl + 8192;
        const int cbase = kc0 + 4 * hi - q_col + 15;
        const int kcb = kc0 + 4 * hi;
        f32x16 cinit;
#pragma unroll
        for (int r = 0; r < 16; ++r) { const int kcol = kcb + (r & 3) + 8 * (r >> 2); cinit[r] = (kcol >= win_lo && kcol < win_lo + 16) ? 0.f : -INFINITY; }
#pragma unroll
        for (int i = 0; i < 4; ++i) { const size_t o_ = (rowb + lo0 * 64 + kc0 + (lane >> 3) + 8 * i) * 512 + h * 64 + (lane & 7) * 8; kc[i] = *(const u32x4*)(KB + o_); vc[i] = *(const u32x4*)(VB + o_); }
        for (int j = 0; j < ntile; ++j) {
            const int key_row = lo0 + j;
            CBAR(); v_tile_store(vl, vc, lane); k_tile_store(kl, kc, lane); CBAR();
            k_frag_load(kl, kf, lane); CBAR();
            if (j + 1 < ntile) {
#pragma unroll
                for (int i = 0; i < 4; ++i) { const size_t o_ = (rowb + (key_row + 1) * 64 + kc0 + (lane >> 3) + 8 * i) * 512 + h * 64 + (lane & 7) * 8; kc[i] = *(const u32x4*)(KB + o_); vc[i] = *(const u32x4*)(VB + o_); }
            }
            f32x16 s = cinit;
#pragma unroll
            for (int ss = 0; ss < 4; ++ss) s = __builtin_amdgcn_mfma_f32_32x32x16_bf16(kf[ss], qf[ss], s, 0, 0, 0);
            const bool row_ok = key_row >= my_lo && key_row < my_lo + 8;
            const LAS float* bp = bl + (row_ok ? key_row - q_row + 7 : 15) * 64 + 16 + cbase;
#pragma unroll
            for (int r = 0; r < 16; ++r) s[r] += bp[(r & 3) + 8 * (r >> 2)];
            softmax_pv(s, m, l, o0, o1, vl, lane);
        }
        const float lt_ = l + __shfl_xor(l, 32), inv = 1.0f / lt_;
        attn_store(YB + (rowb + tq) * 768 + 256 + h * 64, o0, o1, inv, hi);
    }
}

__device__ __forceinline__ void mix_phase(const bf16_t* OA, const float* LSE, bf16_t* YA, int gtid, int nthr) {
    for (int idx = gtid; idx < MTOK * 32; idx += nthr) {
        const int t = idx >> 5, j = (idx >> 3) & 3, dc = idx & 7;
        const float l0 = LSE[(size_t)t * 12 + j], l1 = LSE[(size_t)t * 12 + 4 + j], l2 = LSE[(size_t)t * 12 + 8 + j];
        const float mx = fmaxf(l0, fmaxf(l1, l2));
        float w0 = __builtin_amdgcn_exp2f(l0 - mx), w1 = __builtin_amdgcn_exp2f(l1 - mx), w2 = __builtin_amdgcn_exp2f(l2 - mx);
        const float inv = 1.0f / (w0 + w1 + w2); w0 *= inv; w1 *= inv; w2 *= inv;
        const bf16_t* p = OA + (size_t)t * 768 + j * 64 + dc * 8;
        const u32x4 a = *(const u32x4*)p, bb = *(const u32x4*)(p + 256), c = *(const u32x4*)(p + 512);
        u32x4 w;
#pragma unroll
        for (int i = 0; i < 4; ++i) w[i] = pk2(w0 * bf_lo(a[i]) + w1 * bf_lo(bb[i]) + w2 * bf_lo(c[i]), w0 * bf_hi(a[i]) + w1 * bf_hi(bb[i]) + w2 * bf_hi(c[i]));
        *(u32x4*)(YA + (size_t)t * 768 + j * 64 + dc * 8) = w;
    }
}

__device__ __forceinline__ int srcmap(int type, int n) {
    if (type == 1) { const int pn = n >> 8, bj = (n >> 7) & 1, jj = n & 127; return bj * FF + 128 * pn + jj; }
    if (type == 2 && n < 1536) { const int base = n >= 768 ? 768 : 0, loc = n - base, tile = loc >> 8, c = loc & 255; return base + (4 * tile + ((c >> 5) & 3)) * 64 + 32 * (c >> 7) + (c & 31); }
    return n;
}
struct ConvDesc { const float* W; bf16_t* WT; const float* gain; int K, N, type, item, ldk; };
__device__ __forceinline__ void conv_load(const ConvDesc& c, int lane, f32x4 (&r)[4], unsigned& dst) {
    const int nblk = c.N >> 4, kb = c.item / nblk, nb = c.item - kb * nblk, k0 = 64 * kb, n0 = 16 * nb, lk = lane & 15, ln = lane >> 4;
    const float* p = c.W + (size_t)(k0 + 4 * lk) * c.N + srcmap(c.type, n0) + 4 * ln;
#pragma unroll
    for (int i = 0; i < 4; ++i) r[i] = __builtin_nontemporal_load((const f32x4*)(p + (size_t)i * c.N));
    if (c.gain) { const f32x4 g = *(const f32x4*)(c.gain + k0 + 4 * lk);
#pragma unroll
        for (int i = 0; i < 4; ++i) r[i] = r[i] * g[i]; }
    dst = (unsigned)(n0 + 4 * ln) * (unsigned)c.ldk + k0 + 4 * lk;
}
__device__ __forceinline__ void conv_store(const ConvDesc& c, const f32x4 (&r)[4], unsigned dst) {
#pragma unroll
    for (int j = 0; j < 4; ++j) { u32x2 w; w[0] = pk2(r[0][j], r[1][j]); w[1] = pk2(r[2][j], r[3][j]); *(u32x2*)(c.WT + (dst + (unsigned)j * (unsigned)c.ldk)) = w; }
}
__device__ __forceinline__ ConvDesc conv_desc(const Args& a, bf16_t* wb, int L, int it) {
    ConvDesc c; int r = it; c.gain = nullptr; c.type = 0;
    if (r < 5632) { c.W = a.in[2] + (size_t)L * DM * NUP; c.K = DM; c.N = NUP; c.WT = (bf16_t*)((unsigned char*)wb + W_UP1); c.gain = a.in[1] + L * DM; c.type = 1; c.item = r; c.ldk = c.K; return c; } r -= 5632;
    if (r < 2816) { c.W = a.in[3] + (size_t)L * FF * DM; c.K = FF; c.N = DM; c.WT = (bf16_t*)((unsigned char*)wb + W_DOWN1); c.item = r; c.ldk = c.K; return c; } r -= 2816;
    if (r < 5888) { c.W = a.in[5] + (size_t)L * DM * NIN; c.K = DM; c.N = NIN; c.WT = (bf16_t*)((unsigned char*)wb + W_IN); c.gain = a.in[4] + L * DM; c.type = 2; c.item = r; c.ldk = c.K; return c; } r -= 5888;
    if (r < 256) { c.W = a.in[7] + (size_t)L * 256 * DM; c.K = 256; c.N = DM; c.WT = (bf16_t*)((unsigned char*)wb + W_PA); c.item = r; c.ldk = 768; return c; } r -= 256;
    if (r < 512) { c.W = a.in[8] + (size_t)L * 512 * DM; c.K = 512; c.N = DM; c.WT = (bf16_t*)((unsigned char*)wb + W_PA) + 256; c.item = r; c.ldk = 768; return c; } r -= 512;
    if (r < 1024) { c.W = a.in[9] + (size_t)L * DM * DM; c.K = DM; c.N = DM; c.WT = (bf16_t*)((unsigned char*)wb + W_OUT); c.item = r; c.ldk = c.K; return c; } r -= 1024;
    if (r < 5632) { c.W = a.in[11] + (size_t)L * DM * NUP; c.K = DM; c.N = NUP; c.WT = (bf16_t*)((unsigned char*)wb + W_UP2); c.gain = a.in[10] + L * DM; c.type = 1; c.item = r; c.ldk = c.K; return c; } r -= 5632;
    c.W = a.in[12] + (size_t)L * FF * DM; c.K = FF; c.N = DM; c.WT = (bf16_t*)((unsigned char*)wb + W_DOWN2); c.item = r; c.ldk = c.K; return c;
}
__device__ __forceinline__ float wave_sum(float v) {
#pragma unroll
    for (int o = 1; o < 64; o <<= 1) v += __shfl_xor(v, o);
    return v;
}

typedef unsigned gu32_t;
#define XB_TMO      128
#define XB_XCNT(j)  (256  + 64 * (j))
#define XB_XSUB(j)  (1280 + 64 * (j))
#define XB_XGEN(j)  (2304 + 64 * (j))
#define XB_TOP      3328
#define XB_TOPGEN   3392
#define XCD_BAR_WORDS 3456
#define XB_SPIN_CAP (1u << 18)

__device__ __forceinline__ unsigned xb_ld(unsigned* p)              { return __hip_atomic_load(p, __ATOMIC_RELAXED, __HIP_MEMORY_SCOPE_AGENT); }
__device__ __forceinline__ unsigned xb_add(unsigned* p, unsigned v) { return __hip_atomic_fetch_add(p, v, __ATOMIC_RELAXED, __HIP_MEMORY_SCOPE_AGENT); }
__device__ __forceinline__ unsigned xb_xcc_id() { return (unsigned)__builtin_amdgcn_s_getreg((3 << 11) | 20) & 0xFu; }
#define XB_SPIN(cond, bar) do { unsigned _sp = 0; while (cond) { __builtin_amdgcn_s_sleep(1); \
    if ((++_sp & 255u) == 0u) { if (xb_ld(&(bar)[XB_TMO])) break; if (_sp > XB_SPIN_CAP) { atomicAdd(&(bar)[XB_TMO], 1u); break; } } } } while (0)

struct XcdBarrier {
    unsigned* bar; unsigned x;
    volatile LAS unsigned* st;
};

__device__ __forceinline__ XcdBarrier xcd_barrier_post(unsigned* bar, volatile LAS unsigned* st) {
    XcdBarrier b; b.bar = bar; b.x = xb_xcc_id(); b.st = st;
    if (threadIdx.x == 0) (void)xb_add(&bar[XB_XCNT(b.x)], 1u);
    return b;
}
__device__ __forceinline__ void xcd_barrier_complete(unsigned* bar, unsigned x, unsigned& nloc, unsigned& nx) {
    const unsigned G = gridDim.x * gridDim.y * gridDim.z;
    unsigned sum, cnt, mine, sp = 0u;
    for (;;) {
        sum = 0u; cnt = 0u; mine = 0u;
#pragma unroll
        for (unsigned j = 0; j < 16; ++j) { const unsigned c = xb_ld(&bar[XB_XCNT(j)]); sum += c; cnt += (c > 0u) ? 1u : 0u; mine = (j == x) ? c : mine; }
        if (sum == G) break;
        __builtin_amdgcn_s_sleep(1);
        if ((++sp & 255u) == 0u) { if (xb_ld(&bar[XB_TMO])) break; if (sp > XB_SPIN_CAP) { atomicAdd(&bar[XB_TMO], 1u); break; } }
    }
    nloc = mine > 0u ? mine : 1u; nx = cnt > 0u ? cnt : 1u;
}

__device__ __forceinline__ void xcd_barrier(const XcdBarrier& b) {
    asm volatile("s_waitcnt vmcnt(0)" ::: "memory");
    __syncthreads();
    if (threadIdx.x == 0) {
        unsigned* bar = b.bar;
        __builtin_amdgcn_s_waitcnt(0);
        unsigned nloc = b.st[0], nx = b.st[1];
        if (nloc == 0u) { xcd_barrier_complete(bar, b.x, nloc, nx); b.st[0] = nloc; b.st[1] = nx; }
        const unsigned old = xb_add(&bar[XB_XSUB(b.x)], 1u);
        const unsigned gen = old / nloc;
        if (old + 1u == (gen + 1u) * nloc) {
            __builtin_amdgcn_fence(__ATOMIC_RELEASE, "agent");
            asm volatile("s_waitcnt vmcnt(0)" ::: "memory");
            const unsigned og = xb_add(&bar[XB_TOP], 1u);
            const unsigned tg = og / nx;
            if (og + 1u == (tg + 1u) * nx) xb_add(&bar[XB_TOPGEN], 1u);
            else XB_SPIN(xb_ld(&bar[XB_TOPGEN]) == tg, bar);
            __builtin_amdgcn_fence(__ATOMIC_ACQUIRE, "agent");
            xb_add(&bar[XB_XGEN(b.x)], 1u);
            asm volatile("s_waitcnt vmcnt(0)" ::: "memory");
        } else {
            XB_SPIN(xb_ld(&bar[XB_XGEN(b.x)]) == gen, bar);
            __builtin_amdgcn_fence(__ATOMIC_ACQUIRE, "agent");
            asm volatile("s_waitcnt vmcnt(0)" ::: "memory");
        }
    }
    __syncthreads();
}

__global__ void __launch_bounds__(NTHREADS, 2) fwd(Args a) {
    extern __shared__ __attribute__((aligned(16))) unsigned char lds_raw[];
    LAS unsigned char* lds = (LAS unsigned char*)lds_raw;
    const int G = gridDim.x;
    if (threadIdx.x < 64) ((LAS unsigned*)(lds + 131072))[threadIdx.x] = 0u;
    __syncthreads();
    XcdBarrier bar = xcd_barrier_post((unsigned*)(a.ws + WS_CTL), (volatile LAS unsigned*)(lds + 131072));
    constexpr int VL = 10 + (REP_N - 1);
    for (int vp = a.ph_lo; vp < a.ph_hi; ++vp) {
        const int layer = vp / VL, vsub = vp % VL;
        const int sub = (REP_N == 1 || vsub <= REP_SUB) ? vsub : (vsub < REP_SUB + REP_N ? REP_SUB : vsub - (REP_N - 1));
        const int ph = vp == DEPTH * VL ? NPH - 1 : layer * 10 + sub;
        int tid = threadIdx.x; asm volatile("" : "+v"(tid));
        const int lane = tid & 63, wave = __builtin_amdgcn_readfirstlane(tid >> 6);
        const int gw = blockIdx.x * NWAVES + wave, ngw = G * NWAVES;
        unsigned char* ws = a.ws;
        float* ropec = (float*)(ws + WS_ROPE); float* ropes = ropec + SEQ * 32;
        float* ssq = (float*)(ws + WS_SSQ); float* lse = (float*)(ws + WS_LSE);
        bf16_t* wb0 = (bf16_t*)(ws + WS_W); bf16_t* wb1 = (bf16_t*)((unsigned char*)a.out + 80 * MiB);
        bf16_t* wb = layer == 1 ? wb1 : wb0;
        bf16_t* xb = (bf16_t*)(ws + WS_XB);
        unsigned char* R = ws + WS_R;
        bf16_t *Hb = (bf16_t*)(R + R_H), *QA = (bf16_t*)(R + R_QA), *KA = (bf16_t*)(R + R_KA), *VA = (bf16_t*)(R + R_VA), *QB = (bf16_t*)(R + R_QB), *KB = (bf16_t*)(R + R_KB), *VB = (bf16_t*)(R + R_VB),
               *GA = (bf16_t*)(R + R_GA), *GB = (bf16_t*)(R + R_GB), *YA = (bf16_t*)(R + R_YA), *YB = (bf16_t*)(R + R_YB);
        float* xout = a.out;

        if (ph == NPH - 1) {
            const float* gf = a.in[13];
            for (int row = gw; row < MTOK; row += 2 * ngw) {
                const int row2 = row + ngw < MTOK ? row + ngw : row;
                const float pa = lane < 16 ? ssq[(size_t)row * 16 + lane] : 0.f, pb = lane < 16 ? ssq[(size_t)row2 * 16 + lane] : 0.f;
                const u32x4* xra = (const u32x4*)(xb + (size_t)row * DM) + lane; const u32x4* xrb = (const u32x4*)(xb + (size_t)row2 * DM) + lane;
                const u32x4 ba0 = xra[0], ba1 = xra[64], bb0 = xrb[0], bb1 = xrb[64];
                const float rsa = rsqrtf(wave_sum(pa) * (1.0f / 1024.0f) + RMS_EPS), rsb = rsqrtf(wave_sum(pb) * (1.0f / 1024.0f) + RMS_EPS);
#pragma unroll
                for (int j = 0; j < 2; ++j) {
                    const f32x4 g0 = *((const f32x4*)gf + 2 * lane + 128 * j), g1 = *((const f32x4*)gf + 2 * lane + 128 * j + 1);
#pragma unroll
                    for (int rr = 0; rr < 2; ++rr) {
                        if (rr == 1 && row2 == row) continue;
                        const u32x4 b = rr == 0 ? (j == 0 ? ba0 : ba1) : (j == 0 ? bb0 : bb1); const float rs = rr == 0 ? rsa : rsb;
                        f32x4* orow = (f32x4*)(xout + (size_t)(rr == 0 ? row : row2) * DM);
                        f32x4 v0, v1; v0[0] = bf_lo(b[0]); v0[1] = bf_hi(b[0]); v0[2] = bf_lo(b[1]); v0[3] = bf_hi(b[1]); v1[0] = bf_lo(b[2]); v1[1] = bf_hi(b[2]); v1[2] = bf_lo(b[3]); v1[3] = bf_hi(b[3]);
                        __builtin_nontemporal_store(v0 * rs * g0, orow + 2 * lane + 128 * j); __builtin_nontemporal_store(v1 * rs * g1, orow + 2 * lane + 128 * j + 1);
                    }
                }
            }
        } else if (sub == 0) {
            const int L = layer;
            if (L == 0)
            for (int it = gw; it < 2 * 24576; it += 2 * ngw) {
                const int L0 = it >= 24576; const ConvDesc c0 = conv_desc(a, L0 ? wb1 : wb0, L0, it - L0 * 24576); f32x4 r0[4]; unsigned d0; conv_load(c0, lane, r0, d0);
                const int it1 = it + ngw;
                if (it1 < 2 * 24576) { const int L1 = it1 >= 24576; const ConvDesc c1 = conv_desc(a, L1 ? wb1 : wb0, L1, it1 - L1 * 24576); f32x4 r1[4]; unsigned d1; conv_load(c1, lane, r1, d1); conv_store(c0, r0, d0); conv_store(c1, r1, d1); }
                else conv_store(c0, r0, d0);
            }
            if (L == 0) {
                const float* x = a.in[0];
                for (int row = gw; row < MTOK; row += 2 * ngw) {
                    const int row2 = row + ngw < MTOK ? row + ngw : row;
                    const f32x4* xa = (const f32x4*)(x + (size_t)row * DM) + lane; const f32x4* xc = (const f32x4*)(x + (size_t)row2 * DM) + lane; f32x4 va[4], vb[4]; float sa = 0.f, sb = 0.f;
#pragma unroll
                    for (int j = 0; j < 4; ++j) { va[j] = __builtin_nontemporal_load(xa + 64 * j); vb[j] = __builtin_nontemporal_load(xc + 64 * j); }
#pragma unroll
                    for (int j = 0; j < 4; ++j) { sa += (va[j][0] * va[j][0] + va[j][1] * va[j][1]) + (va[j][2] * va[j][2] + va[j][3] * va[j][3]); sb += (vb[j][0] * vb[j][0] + vb[j][1] * vb[j][1]) + (vb[j][2] * vb[j][2] + vb[j][3] * vb[j][3]); }
                    sa = wave_sum(sa); sb = wave_sum(sb);
                    u32x2* oa = (u32x2*)(xb + (size_t)row * DM) + lane; u32x2* ob = (u32x2*)(xb + (size_t)row2 * DM) + lane;
#pragma unroll
                    for (int j = 0; j < 4; ++j) { u32x2 w; w[0] = pk2(va[j][0], va[j][1]); w[1] = pk2(va[j][2], va[j][3]); oa[64 * j] = w; }
                    if (lane < 16) ssq[(size_t)row * 16 + lane] = lane == 0 ? sa : 0.f;
                    if (row2 != row) {
#pragma unroll
                        for (int j = 0; j < 4; ++j) { u32x2 w; w[0] = pk2(vb[j][0], vb[j][1]); w[1] = pk2(vb[j][2], vb[j][3]); ob[64 * j] = w; }
                        if (lane < 16) ssq[(size_t)row2 * 16 + lane] = lane == 0 ? sb : 0.f;
                    }
                }
                for (int idx = blockIdx.x * NTHREADS + tid; idx < SEQ * 32; idx += G * NTHREADS) {
                    const int pos = idx >> 5, d = idx & 31;
                    const float invf = exp2f(-(float)d * 0.41524101186092033f);
                    const float ang = (float)pos * invf;
                    double rev = (double)ang * 0.15915494309189535; rev -= floor(rev);
                    ropec[idx] = __builtin_amdgcn_cosf((float)rev); ropes[idx] = __builtin_amdgcn_sinf((float)rev);
                }
            }
        } else if (sub == 4) {
            const int gwv = ((G & 7) == 0 ? ((int)(blockIdx.x & 7) * (G >> 3) + (int)(blockIdx.x >> 3)) : (int)blockIdx.x) * NWAVES + wave;
            attnA_phase(QA, (bf16_t*)xout, KA, VA, lse, lds, gwv, ngw, lane, wave);
        } else if (sub == 5) {
            const int gwv = ((G & 7) == 0 ? ((int)(blockIdx.x & 7) * (G >> 3) + (int)(blockIdx.x >> 3)) : (int)blockIdx.x) * NWAVES + wave;
            attnB_phase(QB, KB, VB, YB, a.in[6] + (size_t)layer * 8 * 465, lds, gwv, ngw, lane, wave);
            mix_phase((const bf16_t*)xout, lse, YB, blockIdx.x * NTHREADS + tid, G * NTHREADS);
        } else {
            const int npass = 1;
            for (int pass = 0; pass < npass; ++pass) {
                pg8::Gemm g; EpiAny E; E.R = R; E.xb = xb; E.ssq = ssq; E.ropec = ropec; E.alpha = 0.5f; E.mid_t = -1; int N;
                if (sub == 1 || sub == 8) { g.A = xb; g.Bt = (const bf16_t*)((unsigned char*)wb + (sub == 1 ? W_UP1 : W_UP2)); g.K = DM; N = NUP; E.kind = 0; }
                else if (sub == 2 || sub == 9) { g.A = Hb; g.Bt = (const bf16_t*)((unsigned char*)wb + (sub == 2 ? W_DOWN1 : W_DOWN2)); g.K = FF; N = DM; E.kind = 1; }
                else if (sub == 7) { g.A = GA; g.Bt = (const bf16_t*)((unsigned char*)wb + W_OUT); g.K = DM; N = DM; E.kind = 1; E.alpha = 1.0f; }
                else if (sub == 3) { g.A = xb; g.Bt = (const bf16_t*)((unsigned char*)wb + W_IN); g.K = DM; N = NIN; E.kind = 2; }
                else { g.A = YB; g.Bt = (const bf16_t*)((unsigned char*)wb + W_PA); g.K = 768; N = DM; E.kind = 3; E.mid_t = 4; }
                g.M = MTOK; g.N = N;
                pg8::StaticOrder S; S.init(MTOK, N, G, (int)blockIdx.x);
                pg8::gemm_phase<EpiAny, pg8::StaticOrder, true, true>(lds, g, S, E, tid);
                __syncthreads();
            }
        }
        if (vp + 1 < a.ph_hi && !(ph != NPH - 1 && layer == 1 && sub == 0)) {
            if (a.ph_lo < 0) cg::this_grid().sync();
            for (int s_ = 0; s_ < SYNC_N; ++s_) xcd_barrier(bar);
        }
    }
}

extern "C" void kernel_launch(void* const* d_in, const int* in_sizes, int n_in, void* d_out, int out_size, void* d_ws, size_t ws_size, hipStream_t stream) {
    static int grid = 0;
    if (grid == 0) {
        if (n_in != 14 || in_sizes[0] != MTOK * DM || out_size != MTOK * DM || ws_size < WS_NEED) {
            fprintf(stderr, "kernel_launch: unexpected shapes / workspace (n_in %d, in0 %d, out %d, ws %zu, need %zu)\n", n_in, n_in > 0 ? in_sizes[0] : -1, out_size, ws_size, (size_t)WS_NEED); grid = -1; return; }
        int dev = 0, cus = 0, per_cu = 0;
        hipGetDevice(&dev); hipDeviceGetAttribute(&cus, hipDeviceAttributeMultiprocessorCount, dev);
        if (hipFuncSetAttribute((const void*)fwd, hipFuncAttributeMaxDynamicSharedMemorySize, LDS_BYTES) != hipSuccess) { fprintf(stderr, "kernel_launch: hipFuncSetAttribute failed\n"); grid = -1; return; }
        if (hipOccupancyMaxActiveBlocksPerMultiprocessor(&per_cu, (const void*)fwd, NTHREADS, LDS_BYTES) != hipSuccess || per_cu < 1) { fprintf(stderr, "kernel_launch: occupancy query says %d\n", per_cu); per_cu = 1; }
        (void)hipGetLastError();
        grid = cus * 1;
        fprintf(stderr, "kernel_launch: cus %d per_cu %d grid %d ws %zu\n", cus, per_cu, grid, ws_size);
    }
    if (grid < 0) return;
    Args a{};
    for (int i = 0; i < 14; ++i) a.in[i] = (const float*)d_in[i];
    a.out = (float*)d_out; a.ws = (unsigned char*)d_ws;
    if (hipMemsetAsync((char*)d_ws + WS_CTL, 0, CTL_ZERO_BYTES, stream) != hipSuccess) { fprintf(stderr, "kernel_launch: memset failed\n"); return; }
#if MK_MULTI
    for (int ph = 0; ph < NPH; ++ph) { a.ph_lo = ph; a.ph_hi = ph + 1; hipLaunchKernelGGL(fwd, dim3(grid), dim3(NTHREADS), LDS_BYTES, stream, a); }
#else
    a.ph_lo = 0; a.ph_hi = DEPTH * (10 + (REP_N - 1)) + 1;
    void* kargs[] = {(void*)&a};
    hipError_t e = hipLaunchCooperativeKernel((const void*)fwd, dim3(grid), dim3(NTHREADS), kargs, LDS_BYTES, stream);
    if (e != hipSuccess) fprintf(stderr, "kernel_launch: cooperative launch failed: %s (grid %d)\n", hipGetErrorString(e), grid);
#endif
}
```

```cpp
#include <hip/hip_runtime.h>
#include <hip/hip_cooperative_groups.h>
#include <cstdio>
#include <cstdint>
#include <cmath>
namespace cg = cooperative_groups;

namespace pg8 {
#define PG8_LAS __attribute__((address_space(3)))
typedef unsigned short bf16_t;
typedef short bf16x8 __attribute__((ext_vector_type(8)));
typedef float f32x4 __attribute__((ext_vector_type(4)));
typedef unsigned u32x4 __attribute__((ext_vector_type(4)));
constexpr int BM = 256, BK = 64, HALF = 128, HTB = HALF * BK * 2, STAGE_BYTES = 8 * HTB, NXCD = 8, WGM = 4;

__host__ __device__ __forceinline__ int lds_byte(int r, int c) { const int st = (r >> 4) * 2 + (c >> 5), rr = r & 15, cc = c & 31, ob = rr * 64 + cc * 2; return st * 1024 + (ob ^ (((ob >> 9) & 1) << 5)); }
__host__ __device__ __forceinline__ void stage_rc(int b, int& R, int& C) { const int st = b / 1024, sb = b % 1024, swz = sb ^ (((sb >> 9) & 1) << 5); R = (st >> 1) * 16 + swz / 64; C = (st & 1) * 32 + (swz % 64) / 2; }
__host__ __device__ __forceinline__ int perm32(int rho) { const int n = rho >> 4, i = rho & 15; return 8 * (i >> 2) + 4 * n + (i & 3); }

struct Unit { int pm, pn; };
struct Gemm { const bf16_t* A; const bf16_t* Bt; int M, N, K; };

struct StaticOrder {
    int nM, nN, nwg, G, c;
    __host__ __device__ void init(int M, int N, int G_, int c_) { nM = M / BM; nN = N / BM; nwg = nM * nN; G = G_; c = c_; }
    __host__ __device__ bool next(int i, Unit& u) const {
        const long L = (long)i * G + c; if (L >= nwg) return false;
        int wgid = (int)L; { const int q = nwg / NXCD, r = nwg % NXCD, xcd = wgid % NXCD, off = wgid / NXCD; wgid = (xcd < r ? xcd * (q + 1) : r * (q + 1) + (xcd - r) * q) + off; }
        const int nig = WGM * nN, gid = wgid / nig, fm = gid * WGM, gsz = (nM - fm) < WGM ? (nM - fm) : WGM;
        u.pm = fm + ((wgid % nig) % gsz); u.pn = (wgid % nig) / gsz; return true;
    }
    __device__ __forceinline__ void a_ready(const Unit&) const {}
    __device__ __forceinline__ void done(const Unit&) const {}
};

template <class Epi, class Sched, bool ALIGN_EPI = false, bool SP2 = false>
__device__ __forceinline__ void gemm_phase(PG8_LAS unsigned char* lds, const Gemm g, const Sched& S, const Epi& E, const int tid_in) {
    const int tid = tid_in, wid = __builtin_amdgcn_readfirstlane(tid >> 6), lane = tid & 63, wr = wid >> 2, wc = wid & 3, fr = lane & 15, fq = lane >> 4;
    const int K = g.K, nt = K / BK;
    unsigned voffA[2], voffB[2];
#pragma unroll
    for (int i = 0; i < 2; ++i) { int R, C; stage_rc(tid * 16 + i * 8192, R, C); const int Rb = Epi::PERM ? ((R & ~31) + perm32(R & 31)) : R;
        voffA[i] = (unsigned)(R * K + C) * 2u; voffB[i] = (unsigned)(Rb * K + C) * 2u; }
    const size_t kstep = (size_t)(BK * 2);
    const size_t hstep = (size_t)HALF * K * 2;
    const size_t tstep = 2 * hstep;
    const unsigned ldsw = (unsigned)wid * 1024u;
    const int aoff = lds_byte(wr * 64 + fr, fq * 8), boff = lds_byte(wc * 32 + fr, fq * 8);
#define PG8_SA(b, h) (((b) * 2 + (h)) * HTB)
#define PG8_SB(b, h) ((4 + (b) * 2 + (h)) * HTB)
#define PG8_STAGE(bufoff, gbase, voff) do { _Pragma("unroll") for (int _i = 0; _i < 2; ++_i) \
        __builtin_amdgcn_global_load_lds((const unsigned*)((const char*)(gbase) + (voff)[_i]), (PG8_LAS unsigned*)(lds + (bufoff) + ldsw + _i * 8192), 16, 0, 0); } while (0)
#define PG8_LDA(dst, b, h) do { _Pragma("unroll") for (int m = 0; m < 4; ++m) _Pragma("unroll") for (int k = 0; k < 2; ++k) dst[m][k] = *(const PG8_LAS bf16x8*)(lds + PG8_SA(b, h) + aoff + m * 2048 + k * 1024); } while (0)
#define PG8_LDB(dst, b, h) do { _Pragma("unroll") for (int n = 0; n < 2; ++n) _Pragma("unroll") for (int k = 0; k < 2; ++k) dst[n][k] = *(const PG8_LAS bf16x8*)(lds + PG8_SB(b, h) + boff + n * 2048 + k * 1024); } while (0)
#define PG8_MMA(ai, bj, At, Bt) do { __builtin_amdgcn_s_setprio(1); _Pragma("unroll") for (int m = 0; m < 4; ++m) _Pragma("unroll") for (int n = 0; n < 2; ++n) _Pragma("unroll") for (int k = 0; k < 2; ++k) \
        acc[ai][bj][m][n] = __builtin_amdgcn_mfma_f32_16x16x32_bf16(Bt[n][k], At[m][k], acc[ai][bj][m][n], 0, 0, 0); __builtin_amdgcn_s_setprio(0); } while (0)
#define PG8_WAIT_V(n) asm volatile("s_waitcnt vmcnt(" #n ")" ::: "memory")
#define PG8_WAIT_L(n) asm volatile("s_waitcnt lgkmcnt(" #n ")" ::: "memory")
#define PG8_BAR __builtin_amdgcn_s_barrier()
#define PG8_SCHED __builtin_amdgcn_sched_barrier(0)
    Unit cur, nxt; int ui = 0;
    if (!S.next(0, cur)) return;
    f32x4 acc[2][2][4][2];
#pragma unroll
    for (int a = 0; a < 2; ++a)
#pragma unroll
        for (int b = 0; b < 2; ++b)
#pragma unroll
            for (int m = 0; m < 4; ++m)
#pragma unroll
                for (int n = 0; n < 2; ++n) acc[a][b][m][n] = (f32x4){0.f, 0.f, 0.f, 0.f};
    bf16x8 At[4][2], B0[2][2], B1[2][2];
    const char* cA = (const char*)g.A + (size_t)cur.pm * tstep; const char* cB = (const char*)g.Bt + (size_t)cur.pn * tstep;
    S.a_ready(cur);
    if constexpr (SP2) {
        PG8_STAGE(PG8_SB(0, 0), cB, voffB); PG8_STAGE(PG8_SB(0, 1), cB + hstep, voffB); PG8_STAGE(PG8_SA(0, 0), cA, voffA); PG8_STAGE(PG8_SA(0, 1), cA + hstep, voffA);
        if (wr == 1) PG8_BAR;
        PG8_WAIT_V(2); PG8_BAR;
        PG8_STAGE(PG8_SB(1, 0), cB + kstep, voffB); PG8_STAGE(PG8_SA(1, 0), cA + kstep, voffA); PG8_STAGE(PG8_SB(1, 1), cB + hstep + kstep, voffB);
        PG8_WAIT_V(6); PG8_BAR;
    } else {
        PG8_STAGE(PG8_SB(0, 0), cB, voffB); PG8_STAGE(PG8_SA(0, 0), cA, voffA); PG8_STAGE(PG8_SB(0, 1), cB + hstep, voffB); PG8_STAGE(PG8_SA(0, 1), cA + hstep, voffA);
        if (wr == 1) PG8_BAR;
        PG8_WAIT_V(4); PG8_BAR;
        PG8_STAGE(PG8_SB(1, 0), cB + kstep, voffB); PG8_STAGE(PG8_SA(1, 0), cA + kstep, voffA); PG8_STAGE(PG8_SB(1, 1), cB + hstep + kstep, voffB);
        PG8_WAIT_V(6); PG8_BAR;
    }
    for (;;) {
        const bool has_next = S.next(ui + 1, nxt);
        const char* nA = has_next ? (const char*)g.A + (size_t)nxt.pm * tstep : cA; const char* nB = has_next ? (const char*)g.Bt + (size_t)nxt.pn * tstep : cB;
        for (int t = 0; t < nt; t += 2) {
            if (t == E.mid_t) E.mid(acc, cur, wr, wc, fr, fq);
            const bool last = (t == nt - 2);
            const char* a1 = cA + (size_t)(t + 1) * kstep;
            const char* a2 = last ? nA : cA + (size_t)(t + 2) * kstep; const char* b2 = last ? nB : cB + (size_t)(t + 2) * kstep;
            const char* a3 = a2 + kstep; const char* b3 = b2 + kstep;
            if (last && has_next) S.a_ready(nxt);
            if constexpr (SP2) {
            PG8_LDB(B0, 0, 0); PG8_LDB(B1, 0, 1); PG8_SCHED; PG8_LDA(At, 0, 0); PG8_STAGE(PG8_SA(1, 1), a1 + hstep, voffA);
            PG8_WAIT_V(8); PG8_WAIT_L(0); PG8_BAR; PG8_MMA(0, 0, At, B0); PG8_MMA(0, 1, At, B1); PG8_BAR; PG8_SCHED;
            PG8_LDA(At, 0, 1); PG8_STAGE(PG8_SB(0, 0), b2, voffB); PG8_STAGE(PG8_SB(0, 1), b2 + hstep, voffB); PG8_STAGE(PG8_SA(0, 0), a2, voffA);
            PG8_WAIT_V(8); PG8_WAIT_L(0); PG8_BAR; PG8_MMA(1, 0, At, B0); PG8_MMA(1, 1, At, B1); PG8_BAR; PG8_SCHED;
            PG8_LDB(B0, 1, 0); PG8_LDB(B1, 1, 1); PG8_SCHED; PG8_LDA(At, 1, 0); PG8_STAGE(PG8_SA(0, 1), a2 + hstep, voffA);
            PG8_WAIT_V(8); PG8_WAIT_L(0); PG8_BAR; PG8_MMA(0, 0, At, B0); PG8_MMA(0, 1, At, B1); PG8_BAR; PG8_SCHED;
            PG8_LDA(At, 1, 1); PG8_STAGE(PG8_SB(1, 0), b3, voffB); PG8_STAGE(PG8_SB(1, 1), b3 + hstep, voffB); PG8_STAGE(PG8_SA(1, 0), a3, voffA);
            PG8_WAIT_V(8); PG8_WAIT_L(0); PG8_BAR; PG8_MMA(1, 0, At, B0); PG8_MMA(1, 1, At, B1); PG8_BAR; PG8_SCHED;
            } else {
            PG8_LDB(B0, 0, 0); PG8_SCHED; PG8_LDA(At, 0, 0); PG8_STAGE(PG8_SA(1, 1), a1 + hstep, voffA);
            PG8_WAIT_L(8); PG8_BAR; PG8_WAIT_L(0); PG8_MMA(0, 0, At, B0); PG8_BAR; PG8_SCHED;
            PG8_LDB(B1, 0, 1); PG8_STAGE(PG8_SB(0, 0), b2, voffB);
            PG8_BAR; PG8_WAIT_L(0); PG8_MMA(0, 1, At, B1); PG8_BAR;
            PG8_LDA(At, 0, 1); PG8_STAGE(PG8_SA(0, 0), a2, voffA);
            PG8_BAR; PG8_WAIT_L(0); PG8_MMA(1, 0, At, B0); PG8_BAR; PG8_SCHED;
            PG8_STAGE(PG8_SB(0, 1), b2 + hstep, voffB);
            PG8_WAIT_V(6); PG8_BAR; PG8_MMA(1, 1, At, B1); PG8_BAR;
            PG8_LDB(B0, 1, 0); PG8_SCHED; PG8_LDA(At, 1, 0); PG8_STAGE(PG8_SA(0, 1), a2 + hstep, voffA);
            PG8_WAIT_L(8); PG8_BAR; PG8_WAIT_L(0); PG8_MMA(0, 0, At, B0); PG8_BAR; PG8_SCHED;
            PG8_LDB(B1, 1, 1); PG8_STAGE(PG8_SB(1, 0), b3, voffB);
            PG8_BAR; PG8_WAIT_L(0); PG8_MMA(0, 1, At, B1); PG8_BAR;
            PG8_LDA(At, 1, 1); PG8_STAGE(PG8_SA(1, 0), a3, voffA);
            PG8_BAR; PG8_WAIT_L(0); PG8_MMA(1, 0, At, B0); PG8_BAR; PG8_SCHED;
            PG8_STAGE(PG8_SB(1, 1), b3 + hstep, voffB);
            PG8_WAIT_V(6); PG8_BAR; PG8_MMA(1, 1, At, B1); PG8_BAR;
            }
        }
        if constexpr (ALIGN_EPI) { if (wr == 0) PG8_BAR; }
        if constexpr (!Epi::AFTER_DRAIN) { E(acc, cur, wr, wc, fr, fq); S.done(cur); }
        if (!has_next) break;
#pragma unroll
        for (int a = 0; a < 2; ++a)
#pragma unroll
            for (int b = 0; b < 2; ++b)
#pragma unroll
                for (int m = 0; m < 4; ++m)
#pragma unroll
                    for (int n = 0; n < 2; ++n) acc[a][b][m][n] = (f32x4){0.f, 0.f, 0.f, 0.f};
        cur = nxt; cA = nA; cB = nB; ++ui;
        if constexpr (ALIGN_EPI) { if (wr == 1) PG8_BAR; }
    }
    PG8_WAIT_V(0);
    if constexpr (!ALIGN_EPI) { if (wr == 0) PG8_BAR; }
    PG8_BAR;
    if constexpr (Epi::AFTER_DRAIN) { E.fused(acc, cur, wr, wc, fr, fq, lds, wid, lane); S.done(cur); }
#undef PG8_SA
#undef PG8_SB
#undef PG8_STAGE
#undef PG8_LDA
#undef PG8_LDB
#undef PG8_MMA
#undef PG8_WAIT_V
#undef PG8_WAIT_L
#undef PG8_BAR
#undef PG8_SCHED
}
}

using pg8::bf16_t; using pg8::f32x4; using pg8::u32x4; using pg8::bf16x8;
#define LAS __attribute__((address_space(3)))
typedef float f32x16 __attribute__((ext_vector_type(16)));
typedef short s16x4 __attribute__((ext_vector_type(4)));
typedef short v4i16_t __attribute__((ext_vector_type(4)));
typedef unsigned u32x2 __attribute__((ext_vector_type(2)));
typedef float f32x2_t __attribute__((ext_vector_type(2)));
typedef __bf16 bf16x2_t __attribute__((ext_vector_type(2)));

#ifndef REP_SUB
#define REP_SUB 0
#endif
#ifndef REP_N
#define REP_N 1
#endif
#ifndef SYNC_N
#define SYNC_N 1
#endif
#ifndef H_STORE_BITS
#define H_STORE_BITS "sc0 sc1"
#endif
#ifndef MK_MULTI
#define MK_MULTI 0
#endif

constexpr int BATCH = 16, SEQ = 2048, DM = 1024, MTOK = BATCH * SEQ, FF = 2816, NUP = 2 * FF, NIN = 5888, DEPTH = 2;
constexpr float RMS_EPS = 1e-6f, LOG2E = 1.4426950408889634f, QSCALE = 0.125f * 1.4426950408889634f;
constexpr int NPH = DEPTH * 10 + 1;
constexpr int NTHREADS = 512, NWAVES = 8;
constexpr int LDS_BYTES = 131072 + 1024;

constexpr size_t MiB = 1u << 20;
constexpr size_t WS_CTL = 0, CTL_ZERO_BYTES = 65536;
constexpr size_t WS_ROPE = 1 * MiB;
constexpr size_t WS_SSQ = 2 * MiB;
constexpr size_t WS_LSE = 4 * MiB;
constexpr size_t WS_W = 8 * MiB;
constexpr size_t W_UP1 = 0, W_DOWN1 = 11 * MiB, W_IN = W_DOWN1 + 11 * MiB / 2, W_PA = 28 * MiB, W_PB = W_PA + MiB / 2, W_OUT = W_PB + MiB, W_UP2 = W_OUT + 2 * MiB, W_DOWN2 = W_UP2 + 11 * MiB;
static_assert(W_IN + (size_t)NIN * DM * 2 == W_PA && W_DOWN2 + (size_t)DM * FF * 2 == 48 * MiB, "weight map");
constexpr size_t WS_XB = 56 * MiB;
constexpr size_t WS_R = 120 * MiB;
constexpr size_t R_H = 0;
constexpr size_t R_QA = 0, R_KA = 48 * MiB, R_VA = 96 * MiB, R_QB = 144 * MiB, R_KB = 176 * MiB, R_VB = 208 * MiB, R_GA = 240 * MiB, R_GB = 304 * MiB, R_YA = 368 * MiB, R_YB = R_KA, R_END = 384 * MiB;
constexpr size_t WS_NEED = WS_R + R_END;

struct Args { const float* in[14]; float* out; unsigned char* ws; int ph_lo, ph_hi; };

__device__ __forceinline__ unsigned pk2(float lo, float hi) { f32x2_t v = {lo, hi}; bf16x2_t b = __builtin_convertvector(v, bf16x2_t); return __builtin_bit_cast(unsigned, b); }
__device__ __forceinline__ float bf_lo(unsigned u) { return __uint_as_float(u << 16); }
__device__ __forceinline__ float bf_hi(unsigned u) { return __uint_as_float(u & 0xffff0000u); }
__device__ __forceinline__ float fast_sigmoid(float z) { return __builtin_amdgcn_rcpf(1.0f + __expf(-z)); }

__device__ __forceinline__ float row_rs(const float* ssq, unsigned row, int fq) {
    const f32x4 p = *(const f32x4*)(ssq + (row * 16u + fq * 4));
    float s = (p[0] + p[1]) + (p[2] + p[3]);
    s += __shfl_xor(s, 16); s += __shfl_xor(s, 32);
    return rsqrtf(s * (1.0f / 1024.0f) + RMS_EPS);
}

__device__ __forceinline__ void load_rs8(const float* ssq, unsigned row0, int fq, float (&rs)[8]) {
    f32x4 p[8];
#pragma unroll
    for (int k = 0; k < 8; ++k) p[k] = *(const f32x4*)(ssq + ((row0 + (k >> 2) * 128 + (k & 3) * 16) * 16u + fq * 4));
#pragma unroll
    for (int k = 0; k < 8; ++k) { float s = (p[k][0] + p[k][1]) + (p[k][2] + p[k][3]); s += __shfl_xor(s, 16); s += __shfl_xor(s, 32); rs[k] = rsqrtf(s * (1.0f / 1024.0f) + RMS_EPS); }
}
struct EpiAny {
    static constexpr bool PERM = true, AFTER_DRAIN = false;
    int kind; int mid_t; float alpha; unsigned char* R; bf16_t* xb; float* ssq; const float* ropec;
    __device__ __forceinline__ void mid(f32x4 (&acc)[2][2][4][2], const pg8::Unit& u, int wr, int wc, int fr, int fq) const {
        const bf16_t* GA = (const bf16_t*)(R + R_GA); const bf16_t* GB = (const bf16_t*)(R + R_GB);
        unsigned row0 = u.pm * 256 + wr * 64 + fr; asm volatile("" : "+v"(row0));
        const unsigned col0 = u.pn * 256 + wc * 32 + 8 * fq;
#pragma unroll
        for (int ai = 0; ai < 2; ++ai) {
            u32x4 tv[4][2], gv[4][2];
#pragma unroll
            for (int m = 0; m < 4; ++m)
#pragma unroll
                for (int bj = 0; bj < 2; ++bj) { const unsigned off = (row0 + ai * 128 + m * 16) * (unsigned)DM + col0 + bj * 128; tv[m][bj] = *(const u32x4*)(GA + off); gv[m][bj] = *(const u32x4*)(GB + off); }
#pragma unroll
            for (int m = 0; m < 4; ++m)
#pragma unroll
                for (int bj = 0; bj < 2; ++bj)
#pragma unroll
                    for (int n = 0; n < 2; ++n)
#pragma unroll
                        for (int i = 0; i < 2; ++i) {
                            const unsigned ta = tv[m][bj][2 * n + i], tb = gv[m][bj][2 * n + i];
                            acc[ai][bj][m][n][2 * i] *= bf_lo(ta) * __builtin_amdgcn_rcpf(fmaxf(bf_lo(tb), 1e-30f));
                            acc[ai][bj][m][n][2 * i + 1] *= bf_hi(ta) * __builtin_amdgcn_rcpf(fmaxf(bf_hi(tb), 1e-30f));
                        }
            asm volatile("" ::: "memory");
        }
    }
    __device__ __forceinline__ void operator()(const f32x4 (&acc)[2][2][4][2], const pg8::Unit& u, int wr, int wc, int fr, int fq) const {
        const unsigned row0 = u.pm * 256 + wr * 64 + fr;
        if (kind == 0) {
            bf16_t* H = (bf16_t*)(R + R_H); const unsigned col0 = u.pn * 128 + wc * 32 + 8 * fq;
            float rs8[8]; load_rs8(ssq, row0, fq, rs8);
#pragma unroll
            for (int ai = 0; ai < 2; ++ai)
#pragma unroll
                for (int m = 0; m < 4; ++m) {
                    const unsigned row = row0 + ai * 128 + m * 16; const float rs = rs8[ai * 4 + m];
                    u32x4 w;
#pragma unroll
                    for (int n = 0; n < 2; ++n) {
                        const f32x4 g = acc[ai][0][m][n] * rs, up = acc[ai][1][m][n] * rs; f32x4 hh;
#pragma unroll
                        for (int i = 0; i < 4; ++i) hh[i] = g[i] * fast_sigmoid(g[i]) * up[i];
                        w[2 * n] = pk2(hh[0], hh[1]); w[2 * n + 1] = pk2(hh[2], hh[3]);
                    }
                    { bf16_t* hp_ = H + (row * (unsigned)FF + col0); asm volatile("global_store_dwordx4 %0, %1, off " H_STORE_BITS "\n\ts_nop 1" :: "v"(hp_), "v"(w) : "memory"); }
                }
        } else if (kind == 1) {
            const unsigned col0 = u.pn * 256 + wc * 32 + 8 * fq;
#pragma unroll
            for (int hb = 0; hb < 2; ++hb) { const int ai = hb;
                u32x4 bv[4][2];
#pragma unroll
                for (int m = 0; m < 4; ++m)
#pragma unroll
                    for (int bj = 0; bj < 2; ++bj) { const unsigned off = (row0 + ai * 128 + m * 16) * (unsigned)DM + col0 + bj * 128; bv[m][bj] = *(const u32x4*)(xb + off); }
#pragma unroll
                for (int m = 0; m < 4; ++m) {
                    const unsigned row = row0 + ai * 128 + m * 16; float sq = 0.f;
#pragma unroll
                    for (int bj = 0; bj < 2; ++bj) {
                        const unsigned off = row * (unsigned)DM + col0 + bj * 128; const u32x4 b = bv[m][bj];
                        f32x4 v0, v1;
                        v0[0] = bf_lo(b[0]); v0[1] = bf_hi(b[0]); v0[2] = bf_lo(b[1]); v0[3] = bf_hi(b[1]); v1[0] = bf_lo(b[2]); v1[1] = bf_hi(b[2]); v1[2] = bf_lo(b[3]); v1[3] = bf_hi(b[3]);
                        v0 = v0 + acc[ai][bj][m][0] * alpha; v1 = v1 + acc[ai][bj][m][1] * alpha;
                        u32x4 w; w[0] = pk2(v0[0], v0[1]); w[1] = pk2(v0[2], v0[3]); w[2] = pk2(v1[0], v1[1]); w[3] = pk2(v1[2], v1[3]);
                        *(u32x4*)(xb + off) = w;
                        sq += (v0[0] * v0[0] + v0[1] * v0[1]) + (v0[2] * v0[2] + v0[3] * v0[3]) + (v1[0] * v1[0] + v1[1] * v1[1]) + (v1[2] * v1[2] + v1[3] * v1[3]);
                    }
                    sq += __shfl_xor(sq, 16); sq += __shfl_xor(sq, 32);
                    if (fq == 0) ssq[row * 16u + u.pn * 4 + wc] = sq;
                }
                asm volatile("" ::: "memory");
            }
        } else if (kind == 2) {
            const int pn = u.pn; size_t boff; unsigned ld, pl; int mode; float sc = 1.f;
            if (pn < 3) { boff = R_QA; ld = 768; pl = pn; mode = 1; sc = QSCALE; }
            else if (pn < 6) { boff = R_KA; ld = 768; pl = pn - 3; mode = 1; }
            else if (pn < 9) { boff = R_VA; ld = 768; pl = pn - 6; mode = 0; }
            else if (pn < 11) { boff = R_QB; ld = 512; pl = pn - 9; mode = 0; sc = QSCALE; }
            else if (pn < 13) { boff = R_KB; ld = 512; pl = pn - 11; mode = 0; }
            else if (pn < 15) { boff = R_VB; ld = 512; pl = pn - 13; mode = 0; }
            else if (pn < 19) { boff = R_GA; ld = 1024; pl = pn - 15; mode = 2; }
            else { boff = R_GB; ld = 1024; pl = pn - 19; mode = 2; }
            bf16_t* ob = (bf16_t*)(R + boff);
            float rs8[8]; load_rs8(ssq, row0, fq, rs8);
            if (mode == 1) {
                const unsigned colo = (4 * pl + wc) * 64 + 8 * fq; const float* ropes = ropec + SEQ * 32;
#pragma unroll
                for (int hb = 0; hb < 4; ++hb) { const int ai = hb >> 1, mb = 2 * (hb & 1);
                    f32x4 cv[4][2], sv[4][2];
#pragma unroll
                    for (int m = mb; m < mb + 2; ++m)
#pragma unroll
                        for (int n = 0; n < 2; ++n) { const unsigned ro = ((row0 + ai * 128 + m * 16) & (SEQ - 1)) * 32 + 8 * fq + 4 * n; cv[m][n] = *(const f32x4*)(ropec + ro); sv[m][n] = *(const f32x4*)(ropes + ro); }
#pragma unroll
                    for (int m = mb; m < mb + 2; ++m) {
                        const unsigned row = row0 + ai * 128 + m * 16; const float rs = rs8[ai * 4 + m];
                        u32x4 w1, w2;
#pragma unroll
                        for (int n = 0; n < 2; ++n) {
                            const f32x4 c = cv[m][n], s = sv[m][n];
                            const f32x4 t1 = acc[ai][0][m][n] * rs, t2 = acc[ai][1][m][n] * rs;
                            const f32x4 o1 = (t1 * c - t2 * s) * sc, o2 = (t2 * c + t1 * s) * sc;
                            w1[2 * n] = pk2(o1[0], o1[1]); w1[2 * n + 1] = pk2(o1[2], o1[3]); w2[2 * n] = pk2(o2[0], o2[1]); w2[2 * n + 1] = pk2(o2[2], o2[3]);
                        }
                        const unsigned off = row * 768u + colo;
                        *(u32x4*)(ob + off) = w1; *(u32x4*)(ob + off + 32) = w2;
                    }
                    asm volatile("" ::: "memory");
                }
            } else {
                const unsigned colo = pl * 256 + wc * 32 + 8 * fq;
#pragma unroll
                for (int ai = 0; ai < 2; ++ai)
#pragma unroll
                    for (int m = 0; m < 4; ++m) {
                        const unsigned row = row0 + ai * 128 + m * 16; const float f = rs8[ai * 4 + m] * sc;
#pragma unroll
                        for (int bj = 0; bj < 2; ++bj) {
                            f32x4 v0 = acc[ai][bj][m][0] * f, v1 = acc[ai][bj][m][1] * f;
                            if (mode == 2) {
#pragma unroll
                                for (int i = 0; i < 4; ++i) { v0[i] = fast_sigmoid(v0[i]); v1[i] = fast_sigmoid(v1[i]); }
                            }
                            u32x4 w; w[0] = pk2(v0[0], v0[1]); w[1] = pk2(v0[2], v0[3]); w[2] = pk2(v1[0], v1[1]); w[3] = pk2(v1[2], v1[3]);
                            *(u32x4*)(ob + (row * ld + colo + bj * 128)) = w;
                        }
                    }
            }
        } else {
            bf16_t* GA = (bf16_t*)(R + R_GA); const bf16_t* GB = (const bf16_t*)(R + R_GB);
            const unsigned col0 = u.pn * 256 + wc * 32 + 8 * fq;
#pragma unroll
            for (int hb = 0; hb < 2; ++hb) { const int ai = hb, mb = 0;
                u32x4 gv[4][2];
#pragma unroll
                for (int m = mb; m < mb + 4; ++m)
#pragma unroll
                    for (int bj = 0; bj < 2; ++bj) { const unsigned off = (row0 + ai * 128 + m * 16) * (unsigned)DM + col0 + bj * 128; gv[m][bj] = *(const u32x4*)(GB + off); }
#pragma unroll
                for (int m = mb; m < mb + 4; ++m)
#pragma unroll
                    for (int bj = 0; bj < 2; ++bj) {
                        const unsigned off = (row0 + ai * 128 + m * 16) * (unsigned)DM + col0 + bj * 128;
                        const u32x4 g = gv[m][bj]; const f32x4 a0 = acc[ai][bj][m][0], a1 = acc[ai][bj][m][1]; u32x4 w;
                        w[0] = pk2(bf_lo(g[0]) * a0[0], bf_hi(g[0]) * a0[1]); w[1] = pk2(bf_lo(g[1]) * a0[2], bf_hi(g[1]) * a0[3]);
                        w[2] = pk2(bf_lo(g[2]) * a1[0], bf_hi(g[2]) * a1[1]); w[3] = pk2(bf_lo(g[3]) * a1[2], bf_hi(g[3]) * a1[3]);
                        *(u32x4*)(GA + off) = w;
                    }
                asm volatile("" ::: "memory");
            }
        }
    }
};

__device__ __forceinline__ int crow(int r, int hi) { return (r & 3) + 8 * (r >> 2) + 4 * hi; }
__device__ __forceinline__ s16x4 vtr(LAS unsigned char* p) { return __builtin_bit_cast(s16x4, __builtin_amdgcn_ds_read_tr16_b64_v4i16((LAS v4i16_t*)p)); }
#define CBAR() asm volatile("" ::: "memory")

__device__ __forceinline__ void v_tile_store(LAS unsigned char* vl, const u32x4 (&vc)[4], int lane) {
    const int dc = lane & 7;
#pragma unroll
    for (int i = 0; i < 4; ++i) { const int key = (lane >> 3) + 8 * i; *(LAS u32x4*)(vl + (dc >> 2) * 2048 + key * 64 + (dc & 3) * 16) = vc[i]; }
}
__device__ __forceinline__ void k_tile_store(LAS unsigned char* kl, const u32x4 (&kc)[4], int lane) {
#pragma unroll
    for (int i = 0; i < 4; ++i) *(LAS u32x4*)(kl + ((lane >> 3) + 8 * i) * 144 + (lane & 7) * 16) = kc[i];
}
__device__ __forceinline__ void k_frag_load(LAS unsigned char* kl, bf16x8 (&kf)[4], int lane) {
#pragma unroll
    for (int s = 0; s < 4; ++s) kf[s] = *(const LAS bf16x8*)(kl + (lane & 31) * 144 + s * 32 + (lane >> 5) * 16);
}
__device__ __forceinline__ void softmax_pv(f32x16& s, float& m, float& l, f32x16& o0, f32x16& o1, LAS unsigned char* vl, int lane) {
    const int hi = lane >> 5;
    float mx = s[0];
#pragma unroll
    for (int r = 1; r < 16; ++r) mx = fmaxf(mx, s[r]);
    mx = fmaxf(mx, __shfl_xor(mx, 32));
    if (__any(mx > m + 8.0f)) {
        const float mn = fmaxf(m, mx), alpha = __builtin_amdgcn_exp2f(m - mn);
        m = mn; l *= alpha;
#pragma unroll
        for (int r = 0; r < 16; ++r) { o0[r] *= alpha; o1[r] *= alpha; }
    }
    float sum = 0.f;
#pragma unroll
    for (int r = 0; r < 16; ++r) { s[r] = __builtin_amdgcn_exp2f(s[r] - m); sum += s[r]; }
    l += sum;
    u32x4 p0, p1;
#pragma unroll
    for (int i = 0; i < 4; ++i) { p0[i] = pk2(s[2 * i], s[2 * i + 1]); p1[i] = pk2(s[8 + 2 * i], s[8 + 2 * i + 1]); }
    const bf16x8 pb0 = __builtin_bit_cast(bf16x8, p0), pb1 = __builtin_bit_cast(bf16x8, p1);
    LAS unsigned char* vb = vl + (4 * hi + ((lane & 15) >> 2)) * 64 + (16 * ((lane >> 4) & 1) + 4 * (lane & 3)) * 2;
#pragma unroll
    for (int dt = 0; dt < 2; ++dt) {
#pragma unroll
        for (int ks = 0; ks < 2; ++ks) {
            const s16x4 lo = vtr(vb + dt * 2048 + ks * 1024), hh = vtr(vb + dt * 2048 + ks * 1024 + 512);
            const bf16x8 vf = (bf16x8){lo[0], lo[1], lo[2], lo[3], hh[0], hh[1], hh[2], hh[3]};
            if (dt == 0) o0 = __builtin_amdgcn_mfma_f32_32x32x16_bf16(vf, ks == 0 ? pb0 : pb1, o0, 0, 0, 0);
            else         o1 = __builtin_amdgcn_mfma_f32_32x32x16_bf16(vf, ks == 0 ? pb0 : pb1, o1, 0, 0, 0);
        }
    }
}
__device__ __forceinline__ void attn_store(bf16_t* orow, const f32x16& o0, const f32x16& o1, float inv, int hi) {
#pragma unroll
    for (int g = 0; g < 4; ++g) {
        u32x2 w0, w1;
        w0[0] = pk2(o0[4 * g] * inv, o0[4 * g + 1] * inv); w0[1] = pk2(o0[4 * g + 2] * inv, o0[4 * g + 3] * inv);
        w1[0] = pk2(o1[4 * g] * inv, o1[4 * g + 1] * inv); w1[1] = pk2(o1[4 * g + 2] * inv, o1[4 * g + 3] * inv);
        *(u32x2*)(orow + 8 * g + 4 * hi) = w0; *(u32x2*)(orow + 32 + 8 * g + 4 * hi) = w1;
    }
}

__device__ __forceinline__ void attnA_phase(const bf16_t* QA, bf16_t* OA, const bf16_t* KA, const bf16_t* VA, float* LSE, LAS unsigned char* lds, int gw, int ngw, int lane, int wave) {
    LAS unsigned char* vl = lds + wave * 16384;
    const int q = lane & 31, hi = lane >> 5;
    for (int it = gw; it < BATCH * 12 * 64; it += ngw) {
        const int b = it / 768, rem = it % 768, h = rem >> 6, qt = rem & 63;
        const int dsh = 2 * (h >> 2), tpr = 64 >> dsh, rho = qt >> (6 - dsh), lt = qt & (tpr - 1);
        const size_t rowb = (size_t)b * SEQ;
        const int tq = ((lt * 32 + q) << dsh) + rho;
        const bf16_t* Qp = QA + (rowb + tq) * 768 + h * 64;
        bf16x8 qf[4];
#pragma unroll
        for (int s = 0; s < 4; ++s) qf[s] = *(const bf16x8*)(Qp + 16 * s + 8 * hi);
        const int k_lo = lt - 2 < 0 ? 0 : lt - 2, k_hi = lt + 2 > tpr - 1 ? tpr - 1 : lt + 2;
        float m = -1e30f, l = 0.f; f32x16 o0 = {}, o1 = {};
        bf16x8 kf[4]; u32x4 vc[4], kc[4]; LAS unsigned char* kl = vl + 8192;
#pragma unroll
        for (int i = 0; i < 4; ++i) { const int tv = ((k_lo * 32 + (lane >> 3) + 8 * i) << dsh) + rho; const size_t o_ = (rowb + tv) * 768 + h * 64 + (lane & 7) * 8; kc[i] = *(const u32x4*)(KA + o_); vc[i] = *(const u32x4*)(VA + o_); }
        for (int kt = k_lo; kt <= k_hi; ++kt) {
            CBAR(); v_tile_store(vl, vc, lane); k_tile_store(kl, kc, lane); CBAR();
            k_frag_load(kl, kf, lane); CBAR();
            if (kt < k_hi) {
#pragma unroll
                for (int i = 0; i < 4; ++i) { const int tv = (((kt + 1) * 32 + (lane >> 3) + 8 * i) << dsh) + rho; const size_t o_ = (rowb + tv) * 768 + h * 64 + (lane & 7) * 8; kc[i] = *(const u32x4*)(KA + o_); vc[i] = *(const u32x4*)(VA + o_); }
            }
            f32x16 s = {};
#pragma unroll
            for (int ss = 0; ss < 4; ++ss) s = __builtin_amdgcn_mfma_f32_32x32x16_bf16(kf[ss], qf[ss], s, 0, 0, 0);
            const int dk = kt - lt;
            if (dk == -2) {
#pragma unroll
                for (int r = 0; r < 16; ++r) if (crow(r, hi) < q) s[r] = -INFINITY;
            } else if (dk == 2) {
#pragma unroll
                for (int r = 0; r < 16; ++r) if (crow(r, hi) > q) s[r] = -INFINITY;
            }
            softmax_pv(s, m, l, o0, o1, vl, lane);
        }
        const float lt_ = l + __shfl_xor(l, 32), inv = 1.0f / lt_;
        attn_store(OA + (rowb + tq) * 768 + h * 64, o0, o1, inv, hi);
        if (hi == 0) LSE[(rowb + tq) * 12 + h] = m + __builtin_amdgcn_logf(lt_);
    }
}

__device__ __forceinline__ void attnB_phase(const bf16_t* QB, const bf16_t* KB, const bf16_t* VB, bf16_t* YB, const float* relb, LAS unsigned char* lds, int gw, int ngw, int lane, int wave) {
    LAS unsigned char* vl = lds + wave * 16384; LAS float* bl = (LAS float*)(vl + 4096);
    const int q = lane & 31, hi = lane >> 5; int h_loaded = -1;
    for (int it = gw; it < BATCH * 8 * 64; it += ngw) {
        const int b = it >> 9, rem = it & 511, h = rem >> 6, rp = (rem >> 2) & 15, cb = rem & 3;
        const int q_row = 2 * rp + (q >> 4), q_col = 16 * cb + (q & 15), tq = q_row * 64 + q_col;
        int kc0 = 16 * cb - 8; kc0 = kc0 < 0 ? 0 : (kc0 > 32 ? 32 : kc0);
        int lo0 = 2 * rp - 4; lo0 = lo0 < 0 ? 0 : (lo0 > 24 ? 24 : lo0);
        int lo1 = 2 * rp - 3; lo1 = lo1 < 0 ? 0 : (lo1 > 24 ? 24 : lo1);
        const int ntile = lo1 + 8 - lo0;
        int my_lo = q_row - 4; my_lo = my_lo < 0 ? 0 : (my_lo > 24 ? 24 : my_lo);
        int win_lo = q_col - 8; win_lo = win_lo < 0 ? 0 : (win_lo > 48 ? 48 : win_lo);
        const size_t rowb = (size_t)b * SEQ;
        if (h != h_loaded) {
            CBAR();
            for (int i = lane; i < 16 * 64; i += 64) { const int rr = i >> 6, c = i & 63; float v = rr == 15 ? -INFINITY : 0.f; if (rr < 15 && c >= 16 && c < 47) v = relb[h * 465 + rr * 31 + (c - 16)] * LOG2E; bl[i] = v; }
            CBAR(); h_loaded = h;
        }
        const bf16_t* Qp = QB + (rowb + tq) * 512 + h * 64;
        bf16x8 qf[4];
#pragma unroll
        for (int s = 0; s < 4; ++s) qf[s] = *(const bf16x8*)(Qp + 16 * s + 8 * hi);
        float m = -1e30f, l = 0.f; f32x16 o0 = {}, o1 = {};
        bf16x8 kf[4]; u32x4 vc[4], kc[4]; LAS unsigned char* kl = vl + 8192;
        const int cbase = kc0 + 4 * hi - q_col + 15;
        const int kcb = kc0 + 4 * hi;
        f32x16 cinit;
#pragma unroll
        for (int r = 0; r < 16; ++r) { const int kcol = kcb + (r & 3) + 8 * (r >> 2); cinit[r] = (kcol >= win_lo && kcol < win_lo + 16) ? 0.f : -INFINITY; }
#pragma unroll
        for (int i = 0; i < 4; ++i) { const size_t o_ = (rowb + lo0 * 64 + kc0 + (lane >> 3) + 8 * i) * 512 + h * 64 + (lane & 7) * 8; kc[i] = *(const u32x4*)(KB + o_); vc[i] = *(const u32x4*)(VB + o_); }
        for (int j = 0; j < ntile; ++j) {
            const int key_row = lo0 + j;
            CBAR(); v_tile_store(vl, vc, lane); k_tile_store(kl, kc, lane); CBAR();
            k_frag_load(kl, kf, lane); CBAR();
            if (j + 1 < ntile) {
#pragma unroll
                for (int i = 0; i < 4; ++i) { const size_t o_ = (rowb + (key_row + 1) * 64 + kc0 + (lane >> 3) + 8 * i) * 512 + h * 64 + (lane & 7) * 8; kc[i] = *(const u32x4*)(KB + o_); vc[i] = *(const u32x4*)(VB + o_); }
            }
            f32x16 s = cinit;
#pragma unroll
            for (int ss = 0; ss < 4; ++ss) s = __builtin_amdgcn_mfma_f32_32x32x16_bf16(kf[ss], qf[ss], s, 0, 0, 0);
            const bool row_ok = key_row >= my_lo && key_row < my_lo + 8;
            const LAS float* bp = bl + (row_ok ? key_row - q_row + 7 : 15) * 64 + 16 + cbase;
#pragma unroll
            for (int r = 0; r < 16; ++r) s[r] += bp[(r & 3) + 8 * (r >> 2)];
            softmax_pv(s, m, l, o0, o1, vl, lane);
        }
        const float lt_ = l + __shfl_xor(l, 32), inv = 1.0f / lt_;
        attn_store(YB + (rowb + tq) * 768 + 256 + h * 64, o0, o1, inv, hi);
    }
}

__device__ __forceinline__ void mix_one(const bf16_t* OA, bf16_t* YA, int idx, float l0, float l1, float l2, const u32x4& a, const u32x4& bb, const u32x4& c) {
    const int t = idx >> 5, j = (idx >> 3) & 3, dc = idx & 7;
    const float mx = fmaxf(l0, fmaxf(l1, l2));
    float w0 = __builtin_amdgcn_exp2f(l0 - mx), w1 = __builtin_amdgcn_exp2f(l1 - mx), w2 = __builtin_amdgcn_exp2f(l2 - mx);
    const float inv = 1.0f / (w0 + w1 + w2); w0 *= inv; w1 *= inv; w2 *= inv;
    u32x4 w;
#pragma unroll
    for (int i = 0; i < 4; ++i) w[i] = pk2(w0 * bf_lo(a[i]) + w1 * bf_lo(bb[i]) + w2 * bf_lo(c[i]), w0 * bf_hi(a[i]) + w1 * bf_hi(bb[i]) + w2 * bf_hi(c[i]));
    *(u32x4*)(YA + (unsigned)t * 768u + j * 64 + dc * 8) = w;
}
__device__ __forceinline__ void mix_phase(const bf16_t* OA, const float* LSE, bf16_t* YA, int gtid, int nthr) {
    for (int idx = gtid; idx < MTOK * 32; idx += 4 * nthr) {
        float l0[4], l1[4], l2[4]; u32x4 a[4], bb[4], c[4];
#pragma unroll
        for (int k = 0; k < 4; ++k) { int id = idx + k * nthr; id = id < MTOK * 32 ? id : MTOK * 32 - 1; const unsigned t = id >> 5, j = (id >> 3) & 3, dc = id & 7;
            l0[k] = LSE[t * 12u + j]; l1[k] = LSE[t * 12u + 4 + j]; l2[k] = LSE[t * 12u + 8 + j];
            const bf16_t* p = OA + (t * 768u + j * 64 + dc * 8); a[k] = *(const u32x4*)p; bb[k] = *(const u32x4*)(p + 256); c[k] = *(const u32x4*)(p + 512); }
#pragma unroll
        for (int k = 0; k < 4; ++k) if (idx + k * nthr < MTOK * 32) mix_one(OA, YA, idx + k * nthr, l0[k], l1[k], l2[k], a[k], bb[k], c[k]);
    }
}

__device__ __forceinline__ int srcmap(int type, int n) {
    if (type == 1) { const int pn = n >> 8, bj = (n >> 7) & 1, jj = n & 127; return bj * FF + 128 * pn + jj; }
    if (type == 2 && n < 1536) { const int base = n >= 768 ? 768 : 0, loc = n - base, tile = loc >> 8, c = loc & 255; return base + (4 * tile + ((c >> 5) & 3)) * 64 + 32 * (c >> 7) + (c & 31); }
    return n;
}
struct ConvDesc { const float* W; bf16_t* WT; const float* gain; int K, N, type, item, ldk; };
__device__ __forceinline__ void conv_load(const ConvDesc& c, int lane, f32x4 (&r)[4], unsigned& dst) {
    const int nblk = c.N >> 4, kb = c.item / nblk, nb = c.item - kb * nblk, k0 = 64 * kb, n0 = 16 * nb, lk = lane & 15, ln = lane >> 4;
    const float* p = c.W + (size_t)(k0 + 4 * lk) * c.N + srcmap(c.type, n0) + 4 * ln;
#pragma unroll
    for (int i = 0; i < 4; ++i) r[i] = __builtin_nontemporal_load((const f32x4*)(p + (size_t)i * c.N));
    if (c.gain) { const f32x4 g = *(const f32x4*)(c.gain + k0 + 4 * lk);
#pragma unroll
        for (int i = 0; i < 4; ++i) r[i] = r[i] * g[i]; }
    dst = (unsigned)(n0 + 4 * ln) * (unsigned)c.ldk + k0 + 4 * lk;
}
__device__ __forceinline__ void conv_store(const ConvDesc& c, const f32x4 (&r)[4], unsigned dst) {
#pragma unroll
    for (int j = 0; j < 4; ++j) { u32x2 w; w[0] = pk2(r[0][j], r[1][j]); w[1] = pk2(r[2][j], r[3][j]); *(u32x2*)(c.WT + (dst + (unsigned)j * (unsigned)c.ldk)) = w; }
}
__device__ __forceinline__ ConvDesc conv_desc(const Args& a, bf16_t* wb, int L, int it) {
    ConvDesc c; int r = it; c.gain = nullptr; c.type = 0;
    if (r < 5632) { c.W = a.in[2] + (size_t)L * DM * NUP; c.K = DM; c.N = NUP; c.WT = (bf16_t*)((unsigned char*)wb + W_UP1); c.gain = a.in[1] + L * DM; c.type = 1; c.item = r; c.ldk = c.K; return c; } r -= 5632;
    if (r < 2816) { c.W = a.in[3] + (size_t)L * FF * DM; c.K = FF; c.N = DM; c.WT = (bf16_t*)((unsigned char*)wb + W_DOWN1); c.item = r; c.ldk = c.K; return c; } r -= 2816;
    if (r < 5888) { c.W = a.in[5] + (size_t)L * DM * NIN; c.K = DM; c.N = NIN; c.WT = (bf16_t*)((unsigned char*)wb + W_IN); c.gain = a.in[4] + L * DM; c.type = 2; c.item = r; c.ldk = c.K; return c; } r -= 5888;
    if (r < 256) { c.W = a.in[7] + (size_t)L * 256 * DM; c.K = 256; c.N = DM; c.WT = (bf16_t*)((unsigned char*)wb + W_PA); c.item = r; c.ldk = 768; return c; } r -= 256;
    if (r < 512) { c.W = a.in[8] + (size_t)L * 512 * DM; c.K = 512; c.N = DM; c.WT = (bf16_t*)((unsigned char*)wb + W_PA) + 256; c.item = r; c.ldk = 768; return c; } r -= 512;
    if (r < 1024) { c.W = a.in[9] + (size_t)L * DM * DM; c.K = DM; c.N = DM; c.WT = (bf16_t*)((unsigned char*)wb + W_OUT); c.item = r; c.ldk = c.K; return c; } r -= 1024;
    if (r < 5632) { c.W = a.in[11] + (size_t)L * DM * NUP; c.K = DM; c.N = NUP; c.WT = (bf16_t*)((unsigned char*)wb + W_UP2); c.gain = a.in[10] + L * DM; c.type = 1; c.item = r; c.ldk = c.K; return c; } r -= 5632;
    c.W = a.in[12] + (size_t)L * FF * DM; c.K = FF; c.N = DM; c.WT = (bf16_t*)((unsigned char*)wb + W_DOWN2); c.item = r; c.ldk = c.K; return c;
}
__device__ __forceinline__ float wave_sum(float v) {
#pragma unroll
    for (int o = 1; o < 64; o <<= 1) v += __shfl_xor(v, o);
    return v;
}

typedef unsigned gu32_t;
#define XB_TMO      128
#define XB_XCNT(j)  (256  + 64 * (j))
#define XB_XSUB(j)  (1280 + 64 * (j))
#define XB_XGEN(j)  (2304 + 64 * (j))
#define XB_TOP      3328
#define XB_TOPGEN   3392
#define XCD_BAR_WORDS 3456
#define XB_SPIN_CAP (1u << 18)

__device__ __forceinline__ unsigned xb_ld(unsigned* p)              { return __hip_atomic_load(p, __ATOMIC_RELAXED, __HIP_MEMORY_SCOPE_AGENT); }
__device__ __forceinline__ unsigned xb_add(unsigned* p, unsigned v) { return __hip_atomic_fetch_add(p, v, __ATOMIC_RELAXED, __HIP_MEMORY_SCOPE_AGENT); }
__device__ __forceinline__ unsigned xb_xcc_id() { return (unsigned)__builtin_amdgcn_s_getreg((3 << 11) | 20) & 0xFu; }
#define XB_SPIN(cond, bar) do { unsigned _sp = 0; while (cond) { __builtin_amdgcn_s_sleep(1); \
    if ((++_sp & 255u) == 0u) { if (xb_ld(&(bar)[XB_TMO])) break; if (_sp > XB_SPIN_CAP) { atomicAdd(&(bar)[XB_TMO], 1u); break; } } } } while (0)

struct XcdBarrier {
    unsigned* bar; unsigned x;
    volatile LAS unsigned* st;
};

__device__ __forceinline__ XcdBarrier xcd_barrier_post(unsigned* bar, volatile LAS unsigned* st) {
    XcdBarrier b; b.bar = bar; b.x = xb_xcc_id(); b.st = st;
    if (threadIdx.x == 0) (void)xb_add(&bar[XB_XCNT(b.x)], 1u);
    return b;
}
__device__ __forceinline__ void xcd_barrier_complete(unsigned* bar, unsigned x, unsigned& nloc, unsigned& nx) {
    const unsigned G = gridDim.x * gridDim.y * gridDim.z;
    unsigned sum, cnt, mine, sp = 0u;
    for (;;) {
        sum = 0u; cnt = 0u; mine = 0u;
#pragma unroll
        for (unsigned j = 0; j < 16; ++j) { const unsigned c = xb_ld(&bar[XB_XCNT(j)]); sum += c; cnt += (c > 0u) ? 1u : 0u; mine = (j == x) ? c : mine; }
        if (sum == G) break;
        __builtin_amdgcn_s_sleep(1);
        if ((++sp & 255u) == 0u) { if (xb_ld(&bar[XB_TMO])) break; if (sp > XB_SPIN_CAP) { atomicAdd(&bar[XB_TMO], 1u); break; } }
    }
    nloc = mine > 0u ? mine : 1u; nx = cnt > 0u ? cnt : 1u;
}

__device__ __forceinline__ void xcd_barrier(const XcdBarrier& b) {
    asm volatile("s_waitcnt vmcnt(0)" ::: "memory");
    __syncthreads();
    if (threadIdx.x == 0) {
        unsigned* bar = b.bar;
        __builtin_amdgcn_s_waitcnt(0);
        unsigned nloc = b.st[0], nx = b.st[1];
        if (nloc == 0u) { xcd_barrier_complete(bar, b.x, nloc, nx); b.st[0] = nloc; b.st[1] = nx; }
        const unsigned old = xb_add(&bar[XB_XSUB(b.x)], 1u);
        const unsigned gen = old / nloc;
        if (old + 1u == (gen + 1u) * nloc) {
            __builtin_amdgcn_fence(__ATOMIC_RELEASE, "agent");
            asm volatile("s_waitcnt vmcnt(0)" ::: "memory");
            const unsigned og = xb_add(&bar[XB_TOP], 1u);
            const unsigned tg = og / nx;
            if (og + 1u == (tg + 1u) * nx) xb_add(&bar[XB_TOPGEN], 1u);
            else XB_SPIN(xb_ld(&bar[XB_TOPGEN]) == tg, bar);
            __builtin_amdgcn_fence(__ATOMIC_ACQUIRE, "agent");
            xb_add(&bar[XB_XGEN(b.x)], 1u);
            asm volatile("s_waitcnt vmcnt(0)" ::: "memory");
        } else {
            XB_SPIN(xb_ld(&bar[XB_XGEN(b.x)]) == gen, bar);
            __builtin_amdgcn_fence(__ATOMIC_ACQUIRE, "agent");
            asm volatile("s_waitcnt vmcnt(0)" ::: "memory");
        }
    }
    __syncthreads();
}

__global__ void __launch_bounds__(NTHREADS, 2) fwd(Args a) {
    extern __shared__ __attribute__((aligned(16))) unsigned char lds_raw[];
    LAS unsigned char* lds = (LAS unsigned char*)lds_raw;
    const int G = gridDim.x;
    if (threadIdx.x < 64) ((LAS unsigned*)(lds + 131072))[threadIdx.x] = 0u;
    __syncthreads();
    XcdBarrier bar = xcd_barrier_post((unsigned*)(a.ws + WS_CTL), (volatile LAS unsigned*)(lds + 131072));
    constexpr int VL = 10 + (REP_N - 1);
    for (int vp = a.ph_lo; vp < a.ph_hi; ++vp) {
        const int layer = vp / VL, vsub = vp % VL;
        const int sub = (REP_N == 1 || vsub <= REP_SUB) ? vsub : (vsub < REP_SUB + REP_N ? REP_SUB : vsub - (REP_N - 1));
        const int ph = vp == DEPTH * VL ? NPH - 1 : layer * 10 + sub;
        int tid = threadIdx.x; asm volatile("" : "+v"(tid));
        const int lane = tid & 63, wave = __builtin_amdgcn_readfirstlane(tid >> 6);
        const int gw = blockIdx.x * NWAVES + wave, ngw = G * NWAVES;
        unsigned char* ws = a.ws;
        float* ropec = (float*)(ws + WS_ROPE); float* ropes = ropec + SEQ * 32;
        float* ssq = (float*)(ws + WS_SSQ); float* lse = (float*)(ws + WS_LSE);
        bf16_t* wb0 = (bf16_t*)(ws + WS_W); bf16_t* wb1 = (bf16_t*)((unsigned char*)a.out + 80 * MiB);
        bf16_t* wb = layer == 1 ? wb1 : wb0;
        bf16_t* xb = (bf16_t*)(ws + WS_XB);
        unsigned char* R = ws + WS_R;
        bf16_t *Hb = (bf16_t*)(R + R_H), *QA = (bf16_t*)(R + R_QA), *KA = (bf16_t*)(R + R_KA), *VA = (bf16_t*)(R + R_VA), *QB = (bf16_t*)(R + R_QB), *KB = (bf16_t*)(R + R_KB), *VB = (bf16_t*)(R + R_VB),
               *GA = (bf16_t*)(R + R_GA), *GB = (bf16_t*)(R + R_GB), *YA = (bf16_t*)(R + R_YA), *YB = (bf16_t*)(R + R_YB);
        float* xout = a.out;

        if (ph == NPH - 1) {
            const float* gf = a.in[13];
            for (int row = gw; row < MTOK; row += 2 * ngw) {
                const int row2 = row + ngw < MTOK ? row + ngw : row;
                const float pa = lane < 16 ? ssq[(size_t)row * 16 + lane] : 0.f, pb = lane < 16 ? ssq[(size_t)row2 * 16 + lane] : 0.f;
                const u32x4* xra = (const u32x4*)(xb + (size_t)row * DM) + lane; const u32x4* xrb = (const u32x4*)(xb + (size_t)row2 * DM) + lane;
                const u32x4 ba0 = xra[0], ba1 = xra[64], bb0 = xrb[0], bb1 = xrb[64];
                const float rsa = rsqrtf(wave_sum(pa) * (1.0f / 1024.0f) + RMS_EPS), rsb = rsqrtf(wave_sum(pb) * (1.0f / 1024.0f) + RMS_EPS);
#pragma unroll
                for (int j = 0; j < 2; ++j) {
                    const f32x4 g0 = *((const f32x4*)gf + 2 * lane + 128 * j), g1 = *((const f32x4*)gf + 2 * lane + 128 * j + 1);
#pragma unroll
                    for (int rr = 0; rr < 2; ++rr) {
                        if (rr == 1 && row2 == row) continue;
                        const u32x4 b = rr == 0 ? (j == 0 ? ba0 : ba1) : (j == 0 ? bb0 : bb1); const float rs = rr == 0 ? rsa : rsb;
                        f32x4* orow = (f32x4*)(xout + (size_t)(rr == 0 ? row : row2) * DM);
                        f32x4 v0, v1; v0[0] = bf_lo(b[0]); v0[1] = bf_hi(b[0]); v0[2] = bf_lo(b[1]); v0[3] = bf_hi(b[1]); v1[0] = bf_lo(b[2]); v1[1] = bf_hi(b[2]); v1[2] = bf_lo(b[3]); v1[3] = bf_hi(b[3]);
                        __builtin_nontemporal_store(v0 * rs * g0, orow + 2 * lane + 128 * j); __builtin_nontemporal_store(v1 * rs * g1, orow + 2 * lane + 128 * j + 1);
                    }
                }
            }
        } else if (sub == 0) {
            const int L = layer;
            if (L == 0)
            for (int it = gw; it < 2 * 24576; it += 2 * ngw) {
                const int L0 = it >= 24576; const ConvDesc c0 = conv_desc(a, L0 ? wb1 : wb0, L0, it - L0 * 24576); f32x4 r0[4]; unsigned d0; conv_load(c0, lane, r0, d0);
                const int it1 = it + ngw;
                if (it1 < 2 * 24576) { const int L1 = it1 >= 24576; const ConvDesc c1 = conv_desc(a, L1 ? wb1 : wb0, L1, it1 - L1 * 24576); f32x4 r1[4]; unsigned d1; conv_load(c1, lane, r1, d1); conv_store(c0, r0, d0); conv_store(c1, r1, d1); }
                else conv_store(c0, r0, d0);
            }
            if (L == 0) {
                const float* x = a.in[0];
                for (int row = gw; row < MTOK; row += 2 * ngw) {
                    const int row2 = row + ngw < MTOK ? row + ngw : row;
                    const f32x4* xa = (const f32x4*)(x + (size_t)row * DM) + lane; const f32x4* xc = (const f32x4*)(x + (size_t)row2 * DM) + lane; f32x4 va[4], vb[4]; float sa = 0.f, sb = 0.f;
#pragma unroll
                    for (int j = 0; j < 4; ++j) { va[j] = __builtin_nontemporal_load(xa + 64 * j); vb[j] = __builtin_nontemporal_load(xc + 64 * j); }
#pragma unroll
                    for (int j = 0; j < 4; ++j) { sa += (va[j][0] * va[j][0] + va[j][1] * va[j][1]) + (va[j][2] * va[j][2] + va[j][3] * va[j][3]); sb += (vb[j][0] * vb[j][0] + vb[j][1] * vb[j][1]) + (vb[j][2] * vb[j][2] + vb[j][3] * vb[j][3]); }
                    sa = wave_sum(sa); sb = wave_sum(sb);
                    u32x2* oa = (u32x2*)(xb + (size_t)row * DM) + lane; u32x2* ob = (u32x2*)(xb + (size_t)row2 * DM) + lane;
#pragma unroll
                    for (int j = 0; j < 4; ++j) { u32x2 w; w[0] = pk2(va[j][0], va[j][1]); w[1] = pk2(va[j][2], va[j][3]); oa[64 * j] = w; }
                    if (lane < 16) ssq[(size_t)row * 16 + lane] = lane == 0 ? sa : 0.f;
                    if (row2 != row) {
#pragma unroll
                        for (int j = 0; j < 4; ++j) { u32x2 w; w[0] = pk2(vb[j][0], vb[j][1]); w[1] = pk2(vb[j][2], vb[j][3]); ob[64 * j] = w; }
                        if (lane < 16) ssq[(size_t)row2 * 16 + lane] = lane == 0 ? sb : 0.f;
                    }
                }
                for (int idx = blockIdx.x * NTHREADS + tid; idx < SEQ * 32; idx += G * NTHREADS) {
                    const int pos = idx >> 5, d = idx & 31;
                    const float invf = exp2f(-(float)d * 0.41524101186092033f);
                    const float ang = (float)pos * invf;
                    double rev = (double)ang * 0.15915494309189535; rev -= floor(rev);
                    ropec[idx] = __builtin_amdgcn_cosf((float)rev); ropes[idx] = __builtin_amdgcn_sinf((float)rev);
                }
            }
        } else if (sub == 4) {
            const int gwv = ((G & 7) == 0 ? ((int)(blockIdx.x & 7) * (G >> 3) + (int)(blockIdx.x >> 3)) : (int)blockIdx.x) * NWAVES + wave;
            attnA_phase(QA, (bf16_t*)xout, KA, VA, lse, lds, gwv, ngw, lane, wave);
        } else if (sub == 5) {
            const int gwv = ((G & 7) == 0 ? ((int)(blockIdx.x & 7) * (G >> 3) + (int)(blockIdx.x >> 3)) : (int)blockIdx.x) * NWAVES + wave;
            attnB_phase(QB, KB, VB, YB, a.in[6] + (size_t)layer * 8 * 465, lds, gwv, ngw, lane, wave);
            mix_phase((const bf16_t*)xout, lse, YB, blockIdx.x * NTHREADS + tid, G * NTHREADS);
        } else {
            const int npass = 1;
            for (int pass = 0; pass < npass; ++pass) {
                pg8::Gemm g; EpiAny E; E.R = R; E.xb = xb; E.ssq = ssq; E.ropec = ropec; E.alpha = 0.5f; E.mid_t = -1; int N;
                if (sub == 1 || sub == 8) { g.A = xb; g.Bt = (const bf16_t*)((unsigned char*)wb + (sub == 1 ? W_UP1 : W_UP2)); g.K = DM; N = NUP; E.kind = 0; }
                else if (sub == 2 || sub == 9) { g.A = Hb; g.Bt = (const bf16_t*)((unsigned char*)wb + (sub == 2 ? W_DOWN1 : W_DOWN2)); g.K = FF; N = DM; E.kind = 1; }
                else if (sub == 7) { g.A = GA; g.Bt = (const bf16_t*)((unsigned char*)wb + W_OUT); g.K = DM; N = DM; E.kind = 1; E.alpha = 1.0f; }
                else if (sub == 3) { g.A = xb; g.Bt = (const bf16_t*)((unsigned char*)wb + W_IN); g.K = DM; N = NIN; E.kind = 2; }
                else { g.A = YB; g.Bt = (const bf16_t*)((unsigned char*)wb + W_PA); g.K = 768; N = DM; E.kind = 3; E.mid_t = 4; }
                g.M = MTOK; g.N = N;
                pg8::StaticOrder S; S.init(MTOK, N, G, (int)blockIdx.x);
                pg8::gemm_phase<EpiAny, pg8::StaticOrder, true, true>(lds, g, S, E, tid);
                __syncthreads();
            }
        }
        if (vp + 1 < a.ph_hi && !(ph != NPH - 1 && layer == 1 && sub == 0)) {
            if (a.ph_lo < 0) cg::this_grid().sync();
            for (int s_ = 0; s_ < SYNC_N; ++s_) xcd_barrier(bar);
        }
    }
}

extern "C" void kernel_launch(void* const* d_in, const int* in_sizes, int n_in, void* d_out, int out_size, void* d_ws, size_t ws_size, hipStream_t stream) {
    static int grid = 0;
    if (grid == 0) {
        if (n_in != 14 || in_sizes[0] != MTOK * DM || out_size != MTOK * DM || ws_size < WS_NEED) {
            fprintf(stderr, "kernel_launch: unexpected shapes / workspace (n_in %d, in0 %d, out %d, ws %zu, need %zu)\n", n_in, n_in > 0 ? in_sizes[0] : -1, out_size, ws_size, (size_t)WS_NEED); grid = -1; return; }
        int dev = 0, cus = 0, per_cu = 0;
        hipGetDevice(&dev); hipDeviceGetAttribute(&cus, hipDeviceAttributeMultiprocessorCount, dev);
        if (hipFuncSetAttribute((const void*)fwd, hipFuncAttributeMaxDynamicSharedMemorySize, LDS_BYTES) != hipSuccess) { fprintf(stderr, "kernel_launch: hipFuncSetAttribute failed\n"); grid = -1; return; }
        if (hipOccupancyMaxActiveBlocksPerMultiprocessor(&per_cu, (const void*)fwd, NTHREADS, LDS_BYTES) != hipSuccess || per_cu < 1) { fprintf(stderr, "kernel_launch: occupancy query says %d\n", per_cu); per_cu = 1; }
        (void)hipGetLastError();
        grid = cus * 1;
        fprintf(stderr, "kernel_launch: cus %d per_cu %d grid %d ws %zu\n", cus, per_cu, grid, ws_size);
    }
    if (grid < 0) return;
    Args a{};
    for (int i = 0; i < 14; ++i) a.in[i] = (const float*)d_in[i];
    a.out = (float*)d_out; a.ws = (unsigned char*)d_ws;
    if (hipMemsetAsync((char*)d_ws + WS_CTL, 0, CTL_ZERO_BYTES, stream) != hipSuccess) { fprintf(stderr, "kernel_launch: memset failed\n"); return; }
#if MK_MULTI
    for (int ph = 0; ph < NPH; ++ph) { a.ph_lo = ph; a.ph_hi = ph + 1; hipLaunchKernelGGL(fwd, dim3(grid), dim3(NTHREADS), LDS_BYTES, stream, a); }
#else
    a.ph_lo = 0; a.ph_hi = DEPTH * (10 + (REP_N - 1)) + 1;
    void* kargs[] = {(void*)&a};
    hipError_t e = hipLaunchCooperativeKernel((const void*)fwd, dim3(grid), dim3(NTHREADS), kargs, LDS_BYTES, stream);
    if (e != hipSuccess) fprintf(stderr, "kernel_launch: cooperative launch failed: %s (grid %d)\n", hipGetErrorString(e), grid);
#endif
}
```
